# Optimizing an MI355X kernel written in HIP

```python
import math
import jax, jax.numpy as jnp
from jax import lax
import numpy as np

D_MODEL = 1024
BATCH = 8
SEQ = 2048
DEPTH = 4
DEC_BATCH = 128
DEC_SEQ = 8
PAST_LEN = 16384
PAGE_SIZE = 128

D_RNN = D_MODEL
D_CONV = D_MODEL
N_BLOCKS = 8
BLOCK = D_RNN // N_BLOCKS
CONV4_W = 4
CONV3_W = 3
C_RG = 8.0
ALPHA = (2.0 * DEPTH) ** 0.25
BETA = (8.0 * DEPTH) ** -0.25
LN_EPS = 1e-5
SPLITS = np.cumsum([D_RNN, D_RNN, D_CONV, D_CONV, D_CONV, D_CONV, D_MODEL]).tolist()
N_IN = 2 * D_RNN + 4 * D_CONV + 2 * D_MODEL

kernel_name = "hawk_shortconv_gated_parallel_deepnorm_step"


def _causal_dwconv(buf, u, w):
    width = w.shape[0]
    T = u.shape[1]
    up = jnp.concatenate([buf.astype(u.dtype), u], axis=1)
    y = up[:, 0:T] * w[0]
    for k in range(1, width):
        y = y + up[:, k:k + T] * w[k]
    return y, up[:, T:]


def _rglru(xr, h0, reset, w_a, b_a, w_x, b_x, lam):
    bsz, T, _ = xr.shape
    xb = xr.reshape(bsz, T, N_BLOCKS, BLOCK)
    ga = jnp.einsum('btni,nij->btnj', xb, w_a).reshape(bsz, T, D_RNN) + b_a
    gx = jnp.einsum('btni,nij->btnj', xb, w_x).reshape(bsz, T, D_RNN) + b_x
    r = jax.nn.sigmoid(ga.astype(jnp.float32))
    i = jax.nn.sigmoid(gx.astype(jnp.float32))
    log_a = -C_RG * r * jax.nn.softplus(-lam.astype(jnp.float32))
    a = jnp.exp(log_a)
    mult = jnp.sqrt(-jnp.expm1(2.0 * log_a))
    mult = jnp.where(reset[None, :, None], 1.0, mult)
    b = mult * i * xr.astype(jnp.float32)

    def step(h, ab):
        a_t, b_t = ab
        h = a_t * h + b_t
        return h, h

    hT, hs = lax.scan(step, h0.astype(jnp.float32), (a.swapaxes(0, 1), b.swapaxes(0, 1)))
    return hs.swapaxes(0, 1).astype(xr.dtype), hT.astype(xr.dtype)


def _layernorm(x, g, b):
    xf = x.astype(jnp.float32)
    mu = jnp.mean(xf, axis=-1, keepdims=True)
    var = jnp.mean(jnp.square(xf - mu), axis=-1, keepdims=True)
    y = (xf - mu) * lax.rsqrt(var + LN_EPS)
    return (y * g.astype(jnp.float32) + b.astype(jnp.float32)).astype(x.dtype)


def _layer(x, h0, c4_buf, c3_buf, reset, w_in, b_in, conv4_w, conv4_b, w_rg_a, b_rg_a,
           w_rg_x, b_rg_x, rg_lambda, conv3_w, w_rnn_out, w_conv_out, w_out, ln_g, ln_b):
    z = x @ w_in + b_in
    xr, gr, cb, cc, ch, gc, g_rnn, g_conv = jnp.split(z, SPLITS, axis=-1)
    xr_c, c4_new = _causal_dwconv(c4_buf, xr, conv4_w)
    xr_c = xr_c + conv4_b
    hs, hT = _rglru(xr_c, h0, reset, w_rg_a, b_rg_a, w_rg_x, b_rg_x, rg_lambda)
    y_rnn = (hs * jax.nn.silu(gr)) @ w_rnn_out
    v, c3_new = _causal_dwconv(c3_buf, cc * ch, conv3_w)
    y_conv = (cb * v * jax.nn.silu(gc)) @ w_conv_out
    m = jax.nn.sigmoid(g_rnn) * y_rnn + jax.nn.sigmoid(g_conv) * y_conv
    out = m @ w_out
    x = _layernorm(ALPHA * x + out, ln_g, ln_b)
    return x, hT, c4_new, c3_new


def setup_inputs(seed: int = 0) -> dict:
    key = jax.random.key(seed)
    ks = jax.random.split(key, 24)
    f32 = jnp.float32
    n = lambda k, s, sc: jax.random.normal(k, s, f32) * sc
    u = jax.random.uniform(ks[13], (DEPTH, D_RNN), f32, 0.9, 0.999)
    a_base = u ** (1.0 / C_RG)
    rg_lambda = jnp.log(a_base) - jnp.log1p(-a_base)
    return {
        "x_prompt": n(ks[0], (BATCH, SEQ, D_MODEL), 1.0),
        "x_sample": n(ks[1], (DEC_BATCH, DEC_SEQ, D_MODEL), 1.0),
        "state_rglru": n(ks[2], (DEPTH, DEC_BATCH, D_RNN), 0.5),
        "state_conv4": n(ks[3], (DEPTH, DEC_BATCH, CONV4_W - 1, D_RNN), 1.0),
        "state_conv3": n(ks[4], (DEPTH, DEC_BATCH, CONV3_W - 1, D_CONV), 1.0),
        "w_in": n(ks[5], (DEPTH, D_MODEL, N_IN), D_MODEL ** -0.5),
        "b_in": n(ks[6], (DEPTH, N_IN), 0.02),
        "conv4_w": n(ks[7], (DEPTH, CONV4_W, D_RNN), CONV4_W ** -0.5),
        "conv4_b": n(ks[8], (DEPTH, D_RNN), 0.02),
        "w_rg_a": n(ks[9], (DEPTH, N_BLOCKS, BLOCK, BLOCK), BLOCK ** -0.5),
        "b_rg_a": n(ks[10], (DEPTH, D_RNN), 0.02),
        "w_rg_x": n(ks[11], (DEPTH, N_BLOCKS, BLOCK, BLOCK), BLOCK ** -0.5),
        "b_rg_x": n(ks[12], (DEPTH, D_RNN), 0.02),
        "rg_lambda": rg_lambda,
        "conv3_w": n(ks[14], (DEPTH, CONV3_W, D_CONV), CONV3_W ** -0.5),
        "w_rnn_out": n(ks[15], (DEPTH, D_RNN, D_MODEL), BETA * D_RNN ** -0.5),
        "w_conv_out": n(ks[16], (DEPTH, D_CONV, D_MODEL), BETA * D_CONV ** -0.5),
        "w_out": n(ks[17], (DEPTH, D_MODEL, D_MODEL), BETA * D_MODEL ** -0.5),
        "ln_g": 1.0 + n(ks[18], (DEPTH, D_MODEL), 0.02),
        "ln_b": n(ks[19], (DEPTH, D_MODEL), 0.02),
    }


def reference(x_prompt, x_sample, state_rglru, state_conv4, state_conv3, w_in, b_in, conv4_w,
              conv4_b, w_rg_a, b_rg_a, w_rg_x, b_rg_x, rg_lambda, conv3_w, w_rnn_out,
              w_conv_out, w_out, ln_g, ln_b):
    bp, tp, _ = x_prompt.shape
    ts = x_sample.shape[1]
    reset_p = jnp.arange(tp) == 0
    reset_s = jnp.zeros((ts,), dtype=bool)
    h0_p = jnp.zeros((bp, D_RNN), x_prompt.dtype)
    c4_p = jnp.zeros((bp, CONV4_W - 1, D_RNN), x_prompt.dtype)
    c3_p = jnp.zeros((bp, CONV3_W - 1, D_CONV), x_prompt.dtype)
    yp, ys = x_prompt, x_sample
    ph, pc4, pc3, sh, sc4, sc3 = [], [], [], [], [], []
    for l in range(DEPTH):
        w = (w_in[l], b_in[l], conv4_w[l], conv4_b[l], w_rg_a[l], b_rg_a[l], w_rg_x[l],
             b_rg_x[l], rg_lambda[l], conv3_w[l], w_rnn_out[l], w_conv_out[l], w_out[l],
             ln_g[l], ln_b[l])
        yp, h, c4, c3 = _layer(yp, h0_p, c4_p, c3_p, reset_p, *w)
        ph.append(h); pc4.append(c4); pc3.append(c3)
        ys, h, c4, c3 = _layer(ys, state_rglru[l], state_conv4[l], state_conv3[l], reset_s, *w)
        sh.append(h); sc4.append(c4); sc3.append(c3)
    return (yp, ys, jnp.stack(ph), jnp.stack(pc4), jnp.stack(pc3),
            jnp.stack(sh), jnp.stack(sc4), jnp.stack(sc3))
```

```cpp
#include <hip/hip_runtime.h>
#include <cstdio>
#include <cstdint>

#define LAS __attribute__((address_space(3)))
#define GAS __attribute__((address_space(1)))
typedef _Float16 f16;
typedef _Float16 f16x8 __attribute__((ext_vector_type(8)));
typedef _Float16 f16x4 __attribute__((ext_vector_type(4)));
typedef _Float16 f16x2 __attribute__((ext_vector_type(2)));
typedef float f32x4 __attribute__((ext_vector_type(4)));
typedef float f32x2 __attribute__((ext_vector_type(2)));
typedef unsigned u32x4 __attribute__((ext_vector_type(4)));
typedef unsigned u32x2 __attribute__((ext_vector_type(2)));

constexpr int D = 1024, NIN = 8192, DEPTH = 4, NHEAD = 8, HB = 128;
constexpr int BATCH = 8, SEQ = 2048, DECB = 128, DECS = 8;
constexpr int MP = BATCH * SEQ, MS = DECB * DECS, M = MP + MS;
constexpr int NRT = M / 256;
constexpr float LN_EPS = 1e-5f;
constexpr float ALPHA = 1.681792830507429f;
constexpr float LOG2E = 1.4426950408889634f, LN2 = 0.6931471805599453f;
constexpr size_t O_Y = 0;
constexpr size_t O_RP = (size_t)M * D;
constexpr size_t O_C4P = O_RP + (size_t)DEPTH * BATCH * D;
constexpr size_t O_C3P = O_C4P + (size_t)DEPTH * BATCH * 3 * D;
constexpr size_t O_RS = O_C3P + (size_t)DEPTH * BATCH * 2 * D;
constexpr size_t O_C4S = O_RS + (size_t)DEPTH * DECB * D;
constexpr size_t O_C3S = O_C4S + (size_t)DEPTH * DECB * 3 * D;
constexpr size_t O_END = O_C3S + (size_t)DEPTH * DECB * 2 * D;

constexpr size_t MiB = 1u << 20;
constexpr size_t WS_CTL = 0, CTL_ZERO_BYTES = 4 * MiB;
constexpr size_t WS_GRAN = 64 * 1024;
constexpr size_t WS_HGRAN = 1280 * 1024;
constexpr size_t WS_CGRAN = 2880 * 1024;
constexpr size_t WS_C1 = 4 * MiB;
constexpr size_t WS_C2 = WS_C1 + 128 * 1024;
constexpr size_t WS_NSP = WS_C2 + 128 * 1024;
constexpr size_t WS_STATS = 5 * MiB;
constexpr size_t WS_WG = 7 * MiB;
constexpr size_t WS_WIN = 10 * MiB;
constexpr size_t WS_WRC = 74 * MiB;
constexpr size_t WS_WO = 90 * MiB;
constexpr size_t ACT = (size_t)M * D * 2;
constexpr size_t WS_S16 = 98 * MiB;
constexpr size_t WS_XR = WS_S16 + ACT, WS_SGR = WS_XR + ACT, WS_Q = WS_SGR + ACT, WS_P = WS_Q + ACT, WS_GR = WS_P + ACT, WS_GC = WS_GR + ACT;
constexpr size_t WS_U = WS_GC + ACT;
constexpr size_t WS_M16 = WS_XR;
constexpr size_t WS_END = WS_U + 2 * ACT;
constexpr int CW_ERR = 0;
constexpr int CW_BAR = 1024;

constexpr int RING_BYTES = 131072;
constexpr int TAB_OFF = RING_BYTES;
constexpr int LDS_BYTES = 149504;
constexpr int MISC_OFF = LDS_BYTES - 256;
constexpr int XC_STRIDE = 272;
constexpr int XC_OFF = 0, SG_OFF = 256 * XC_STRIDE;
constexpr int ROWTAB_OFF = SG_OFF + 256 * XC_STRIDE;
constexpr int CONV_HALO_OFF = ROWTAB_OFF + 2048;
constexpr int PF_DUMP_OFF = CONV_HALO_OFF;
constexpr int C1C2_OFF = CONV_HALO_OFF + 2048;
static_assert(C1C2_OFF + 4096 <= MISC_OFF, "P2 LDS");

#define RLX_AGENT __ATOMIC_RELAXED, __HIP_MEMORY_SCOPE_AGENT
#define LDS_WAIT() asm volatile("s_waitcnt lgkmcnt(0)" ::: "memory")
#define VM_WAIT() asm volatile("s_waitcnt vmcnt(0)" ::: "memory")

__device__ __forceinline__ int lane_id() { unsigned z = 0u; asm volatile("" : "+v"(z)); return (int)__builtin_amdgcn_mbcnt_hi(~0u, __builtin_amdgcn_mbcnt_lo(~0u, z)); }
namespace g8 {
__device__ __forceinline__ int opq(int x) { asm volatile("" : "+v"(x)); return x; }
constexpr int BM = 256, BK = 64, HALF = 128, HTB = HALF * BK * 2, STAGE_BYTES = 8 * HTB, NXCD = 8, WGM = 8;
__host__ __device__ __forceinline__ int lds_byte(int r, int c) { const int st = (r >> 4) * 2 + (c >> 5), rr = r & 15, cc = c & 31, ob = rr * 64 + cc * 2; return st * 1024 + (ob ^ (((ob >> 9) & 1) << 5)); }
__host__ __device__ __forceinline__ void stage_rc(int b, int& R, int& C) { const int st = b / 1024, sb = b % 1024, swz = sb ^ (((sb >> 9) & 1) << 5); R = (st >> 1) * 16 + swz / 64; C = (st & 1) * 32 + (swz % 64) / 2; }
__host__ __device__ __forceinline__ int perm32(int rho) { const int n = rho >> 4, i = rho & 15; return 8 * (i >> 2) + 4 * n + (i & 3); }

struct Unit { int pm, pn; };
struct Gemm { const f16* A; const f16* Bt; int M, N, K; };

struct StaticOrder {
    int nM, nN, nwg, G, c, mode;
    __host__ __device__ void init(int M_, int N_, int G_, int c_) { nM = M_ / BM; nN = N_ / BM; nwg = nM * nN; G = G_; c = c_; mode = 0; }
    __host__ __device__ bool next(int i, Unit& u) const {
        if (mode == 1) {
            const int x = c & 7, j = c >> 3, q = j >> 3, r = j & 7;
            if (i < 8) { const unsigned long long t = q == 0 ? 0x1B0A1A0919081800ull : q == 1 ? 0x1F0D1E0C1D0B1C01ull : q == 2 ? 0x121110040F030E02ull : 0x1716150714061305ull;
                u.pm = 8 * x + r; u.pn = (int)((t >> (8 * i)) & 0xffu); return true; }
            if (i == 8 && q < 2) { const int s_ = q * 8 + r; u.pm = 64 + (s_ & 3); u.pn = x + 8 * (s_ >> 2); return true; }
            return false;
        }
        const long L = (long)i * G + c; if (L >= nwg) return false;
        int wgid = (int)L; { const int q = nwg / NXCD, r = nwg % NXCD, xcd = wgid % NXCD, off = wgid / NXCD; wgid = (xcd < r ? xcd * (q + 1) : r * (q + 1) + (xcd - r) * q) + off; }
        const int nig = WGM * nN, gid = wgid / nig, fm = gid * WGM, gsz = (nM - fm) < WGM ? (nM - fm) : WGM;
        u.pm = fm + ((wgid % nig) % gsz); u.pn = (wgid % nig) / gsz; return true;
    }
};

template <class Epi>
__device__ __forceinline__ void gemm_phase(LAS unsigned char* lds, const Gemm g, const StaticOrder& S, const Epi& E, const int wid, const int flags) {
    const int lane = opq(lane_id()), tid = wid * 64 + lane, wr = wid >> 2, wc = wid & 3, fr = lane & 15, fq = lane >> 4;
    const int K = g.K, nt = K / BK;
    unsigned voffA[2], voffB[2];
#pragma unroll
    for (int i = 0; i < 2; ++i) { int R, C; stage_rc(tid * 16 + i * 8192, R, C); const int Rb = Epi::PERM ? ((R & ~31) + perm32(R & 31)) : R;
        voffA[i] = (unsigned)(R * K + C) * 2u; voffB[i] = (unsigned)(Rb * K + C) * 2u; }
    const size_t kstep = (size_t)(BK * 2);
    const size_t hstep = (size_t)HALF * K * 2;
    const size_t tstep = 2 * hstep;
    const unsigned ldsw = (unsigned)wid * 1024u;
    const int aoff = lds_byte(wr * 64 + fr, fq * 8), boff = lds_byte(wc * 32 + fr, fq * 8);
#define G8_SA(b, h) (((b) * 2 + (h)) * HTB)
#define G8_SB(b, h) ((4 + (b) * 2 + (h)) * HTB)
#define G8_STAGE(bufoff, gbase, voff) do { _Pragma("unroll") for (int _i = 0; _i < 2; ++_i) \
        __builtin_amdgcn_global_load_lds((const unsigned*)((const char*)(gbase) + (voff)[_i]), (LAS unsigned*)(lds + (bufoff) + ldsw + _i * 8192), 16, 0, 0); } while (0)
#define G8_LDA(dst, b, h) do { _Pragma("unroll") for (int m = 0; m < 4; ++m) _Pragma("unroll") for (int k = 0; k < 2; ++k) dst[m][k] = *(const LAS f16x8*)(lds + G8_SA(b, h) + aoff + m * 2048 + k * 1024); } while (0)
#define G8_LDB(dst, b, h) do { _Pragma("unroll") for (int n = 0; n < 2; ++n) _Pragma("unroll") for (int k = 0; k < 2; ++k) dst[n][k] = *(const LAS f16x8*)(lds + G8_SB(b, h) + boff + n * 2048 + k * 1024); } while (0)
#define G8_MMA(ai, bj, At, Bt) do { __builtin_amdgcn_s_setprio(1); _Pragma("unroll") for (int m = 0; m < 4; ++m) _Pragma("unroll") for (int n = 0; n < 2; ++n) _Pragma("unroll") for (int k = 0; k < 2; ++k) \
        acc[ai][bj][m][n] = __builtin_amdgcn_mfma_f32_16x16x32_f16(Bt[n][k], At[m][k], acc[ai][bj][m][n], 0, 0, 0); __builtin_amdgcn_s_setprio(0); } while (0)
#define G8_WAIT_V(n) asm volatile("s_waitcnt vmcnt(" #n ")" ::: "memory")
#define G8_WAIT_L(n) asm volatile("s_waitcnt lgkmcnt(" #n ")" ::: "memory")
#define G8_BAR __builtin_amdgcn_s_barrier()
#define G8_SCHED __builtin_amdgcn_sched_barrier(0)
    Unit cur, nxt; int ui = 0;
    if (!S.next(0, cur)) return;
    const char* cA = (const char*)g.A + (size_t)cur.pm * tstep; const char* cB = (const char*)g.Bt + (size_t)cur.pn * tstep;
    bool pro = true;
    for (;;) {
        f32x4 acc[2][2][4][2];
#pragma unroll
        for (int a = 0; a < 2; ++a)
#pragma unroll
            for (int b = 0; b < 2; ++b)
#pragma unroll
                for (int m = 0; m < 4; ++m)
#pragma unroll
                    for (int n = 0; n < 2; ++n) acc[a][b][m][n] = (f32x4){0.f, 0.f, 0.f, 0.f};
        f16x8 At[4][2], B0[2][2], B1[2][2];
        const bool has_next = S.next(ui + 1, nxt);
        bool drain = false; if constexpr (Epi::HAS_DRAIN) drain = E.drains(cur);
        if (pro) {
            G8_STAGE(G8_SB(0, 0), cB, voffB); G8_STAGE(G8_SB(0, 1), cB + hstep, voffB); G8_STAGE(G8_SA(0, 0), cA, voffA); G8_STAGE(G8_SA(0, 1), cA + hstep, voffA);
            if (wr == 1) G8_BAR;
            G8_WAIT_V(2); G8_BAR;
            G8_STAGE(G8_SB(1, 0), cB + kstep, voffB); G8_STAGE(G8_SA(1, 0), cA + kstep, voffA); G8_STAGE(G8_SB(1, 1), cB + hstep + kstep, voffB);
            G8_WAIT_V(6); G8_BAR;
        }
        if constexpr (Epi::HAS_PRELOAD) E.preload(cur, lds, wid, lane, ui & 1);
        const bool chain = has_next && !drain;
        const char* nA = chain ? (const char*)g.A + (size_t)nxt.pm * tstep : cA; const char* nB = chain ? (const char*)g.Bt + (size_t)nxt.pn * tstep : cB;
        for (int t = 0; t < nt; t += 2) {
            const bool last = (t == nt - 2);
            const char* a1 = cA + (size_t)(t + 1) * kstep;
            const char* a2 = last ? nA : cA + (size_t)(t + 2) * kstep; const char* b2 = last ? nB : cB + (size_t)(t + 2) * kstep;
            const char* a3 = a2 + kstep; const char* b3 = b2 + kstep;
            if constexpr (Epi::HAS_MID) { if (t == nt / 2 && !(flags & 2)) E.mid(acc, cur, wr, wc, fr, fq); }
            G8_LDB(B0, 0, 0); G8_LDB(B1, 0, 1); G8_SCHED; G8_LDA(At, 0, 0); G8_STAGE(G8_SA(1, 1), a1 + hstep, voffA);
            G8_WAIT_V(8); G8_WAIT_L(0); G8_BAR; G8_MMA(0, 0, At, B0); G8_MMA(0, 1, At, B1); G8_BAR; G8_SCHED;
            G8_LDA(At, 0, 1); G8_STAGE(G8_SB(0, 0), b2, voffB); G8_STAGE(G8_SB(0, 1), b2 + hstep, voffB); G8_STAGE(G8_SA(0, 0), a2, voffA);
            G8_WAIT_V(8); G8_WAIT_L(0); G8_BAR; G8_MMA(1, 0, At, B0); G8_MMA(1, 1, At, B1); G8_BAR; G8_SCHED;
            G8_LDB(B0, 1, 0); G8_LDB(B1, 1, 1); G8_SCHED; G8_LDA(At, 1, 0); G8_STAGE(G8_SA(0, 1), a2 + hstep, voffA);
            G8_WAIT_V(8); G8_WAIT_L(0); G8_BAR; G8_MMA(0, 0, At, B0); G8_MMA(0, 1, At, B1); G8_BAR; G8_SCHED;
            G8_LDA(At, 1, 1); G8_STAGE(G8_SB(1, 0), b3, voffB); G8_STAGE(G8_SB(1, 1), b3 + hstep, voffB); G8_STAGE(G8_SA(1, 0), a3, voffA);
            G8_WAIT_V(8); G8_WAIT_L(0); G8_BAR; G8_MMA(1, 0, At, B0); G8_MMA(1, 1, At, B1); G8_BAR; G8_SCHED;
        }
        if (drain) {
            G8_WAIT_V(0); if (wr == 0) G8_BAR; G8_BAR;
            if (has_next) {
                const char* pb = (const char*)g.Bt + (size_t)nxt.pn * tstep + (size_t)((unsigned)(tid >> 1) * (unsigned)(K * 2) + (unsigned)(tid & 1) * 128u);
                __builtin_amdgcn_global_load_lds((const unsigned*)pb, (LAS unsigned*)(lds + PF_DUMP_OFF + wid * 256), 4, 0, 0);
            }
            if constexpr (Epi::HAS_DRAIN) { if (!(flags & 1)) E.fused(acc, cur, wr, wc, fr, fq, lds, wid); }
            pro = true;
        } else {
            if (wr == 0) G8_BAR;
            if (!(flags & 1)) E(acc, cur, wr, wc, fr, fq); else { asm volatile("" :: "v"(acc[0][0][0][0]), "v"(acc[1][1][3][1]), "v"(acc[0][1][2][0]), "v"(acc[1][0][1][1])); if (Epi::USES_BAR) { G8_BAR; } }
            pro = false;
        }
        if (!has_next) { if (!drain) { G8_WAIT_V(0); G8_BAR; } break; }
        cur = nxt; cA = (const char*)g.A + (size_t)cur.pm * tstep; cB = (const char*)g.Bt + (size_t)cur.pn * tstep; ++ui;
        if (!drain) { if (wr == 1) G8_BAR; }
    }
#undef G8_SA
#undef G8_SB
#undef G8_STAGE
#undef G8_LDA
#undef G8_LDB
#undef G8_MMA
#undef G8_WAIT_V
#undef G8_WAIT_L
#undef G8_SCHED
}
}
#define G8_BAR __builtin_amdgcn_s_barrier()

__device__ __forceinline__ int opaque_v(int x) { asm volatile("" : "+v"(x)); return x; }
__device__ __forceinline__ unsigned opaque_u(unsigned x) { asm volatile("" : "+v"(x)); return x; }
__device__ __forceinline__ int opaque_s(int x) { asm volatile("" : "+s"(x)); return x; }
__device__ __forceinline__ unsigned long long opaque_s64(unsigned long long x) { asm volatile("" : "+s"(x)); return x; }
constexpr bool WT_STORES = false;
__device__ __forceinline__ void st16(void* p, u32x4 v) {
    if (WT_STORES) asm volatile("global_store_dwordx4 %0, %1, off sc1\n\ts_nop 1" :: "v"(p), "v"(v) : "memory");
    else *(u32x4*)p = v;
}
__device__ __forceinline__ float fexp2(float x) { return __builtin_amdgcn_exp2f(x); }
__device__ __forceinline__ float frcp(float x) { return __builtin_amdgcn_rcpf(x); }
__device__ __forceinline__ float sigmoidf_(float x) { return frcp(1.f + fexp2(-LOG2E * x)); }
__device__ __forceinline__ float siluf_(float x) { return x * sigmoidf_(x); }
__device__ __forceinline__ unsigned pk2h(float lo, float hi) { f16x2 h; h.x = (f16)lo; h.y = (f16)hi; return __builtin_bit_cast(unsigned, h); }
__device__ __forceinline__ u32x4 pk8h(const f32x4 a, const f32x4 b) { u32x4 w; w.x = pk2h(a[0], a[1]); w.y = pk2h(a[2], a[3]); w.z = pk2h(b[0], b[1]); w.w = pk2h(b[2], b[3]); return w; }
__device__ __forceinline__ u32x2 pk8q(const f32x4 a, const f32x4 b) { int lo = 0, hi = 0;
    lo = __builtin_amdgcn_cvt_pk_fp8_f32(a[0], a[1], lo, false); lo = __builtin_amdgcn_cvt_pk_fp8_f32(a[2], a[3], lo, true);
    hi = __builtin_amdgcn_cvt_pk_fp8_f32(b[0], b[1], hi, false); hi = __builtin_amdgcn_cvt_pk_fp8_f32(b[2], b[3], hi, true);
    return (u32x2){(unsigned)lo, (unsigned)hi}; }
__device__ __forceinline__ void unpk8q(unsigned lo, unsigned hi, float (&v)[8]) {
    const f32x2 a = __builtin_amdgcn_cvt_pk_f32_fp8((int)lo, false), b = __builtin_amdgcn_cvt_pk_f32_fp8((int)lo, true), c = __builtin_amdgcn_cvt_pk_f32_fp8((int)hi, false), d = __builtin_amdgcn_cvt_pk_f32_fp8((int)hi, true);
    v[0] = a[0]; v[1] = a[1]; v[2] = b[0]; v[3] = b[1]; v[4] = c[0]; v[5] = c[1]; v[6] = d[0]; v[7] = d[1]; }
__device__ __forceinline__ void unpk8h(const u32x4 w, float (&v)[8]) {
    const f16x8 h = __builtin_bit_cast(f16x8, w);
#pragma unroll
    for (int e = 0; e < 8; ++e) v[e] = (float)h[e];
}

struct MixCtx {
    f16* U; const f16* WG;
    const float *conv4_w, *conv4_b, *b_a, *b_x, *nsp;
    const float *st_h, *st_c4;
    unsigned long long *gran, *hgran; unsigned* err; float* out; int layer, flags;
};

template <bool SAMPLE>
__device__ __forceinline__ void rnn_mixer(const MixCtx& C, LAS unsigned char* lds, int pm, int j, const int wave) {
    const int lane = opaque_v(lane_id()), tid = wave * 64 + lane;
    const int rb = tid >> 4, o = tid & 15, r0 = rb * 8, cb = 128 * j + 8 * o;
    const int grow0 = pm * 256 + r0;
    const int chunk = pm & 7, sq = pm >> 3;
    const unsigned epoch = (unsigned)C.layer + 1u;
    const unsigned lb = opaque_u((unsigned)(r0 * XC_STRIDE + 16 * o));
    if (C.flags & 16) return;
    {
        float up[11][8];
#pragma unroll
        for (int i = 0; i < 8; ++i) unpk8h(*(const LAS u32x4*)(lds + XC_OFF + lb + i * XC_STRIDE), up[3 + i]);
        if (SAMPLE) {
            const int b = (grow0 - MP) >> 3;
#pragma unroll
            for (int i = 0; i < 3; ++i) { const float* sp = C.st_c4 + ((size_t)b * 3 + i) * D + cb; const f32x4 a = *(const f32x4*)sp, c = *(const f32x4*)(sp + 4);
#pragma unroll
                for (int e = 0; e < 4; ++e) { up[i][e] = a[e]; up[i][4 + e] = c[e]; } }
        } else if (rb > 0) {
#pragma unroll
            for (int i = 0; i < 3; ++i) unpk8h(*(const LAS u32x4*)(lds + XC_OFF + lb + (i - 3) * XC_STRIDE), up[i]);
        } else if (chunk == 0) {
#pragma unroll
            for (int i = 0; i < 3; ++i)
#pragma unroll
                for (int e = 0; e < 8; ++e) up[i][e] = 0.f;
        } else {
            const unsigned long long* hp = C.hgran + ((size_t)((pm - 1) * 8 + j) * 3) * HB + 8 * o;
            unsigned spins = 0;
            for (;;) {
                bool ok = true;
#pragma unroll
                for (int i = 0; i < 3; ++i)
#pragma unroll
                    for (int e = 0; e < 8; ++e) { const unsigned long long x = __hip_atomic_load(hp + i * HB + e, RLX_AGENT); up[i][e] = __uint_as_float((unsigned)x); ok = ok && ((unsigned)(x >> 32) == epoch); }
                if (ok) break;
                __builtin_amdgcn_s_sleep(2);
                if (++spins > (1u << 22)) { __hip_atomic_store(C.err, 1u, RLX_AGENT); break; }
            }
        }
        float w4[4][8], b4[8];
#pragma unroll
        for (int k = 0; k < 4; ++k) { const f32x4 a = *(const f32x4*)(C.conv4_w + k * D + cb), c = *(const f32x4*)(C.conv4_w + k * D + cb + 4);
#pragma unroll
            for (int e = 0; e < 4; ++e) { w4[k][e] = a[e]; w4[k][4 + e] = c[e]; } }
        { const f32x4 a = *(const f32x4*)(C.conv4_b + cb), c = *(const f32x4*)(C.conv4_b + cb + 4);
#pragma unroll
            for (int e = 0; e < 4; ++e) { b4[e] = a[e]; b4[4 + e] = c[e]; } }
        LDS_WAIT(); __syncthreads();
#pragma unroll
        for (int rr = 0; rr < 8; ++rr) {
            f16x8 h;
#pragma unroll
            for (int e = 0; e < 8; ++e) h[e] = (f16)(b4[e] + w4[0][e] * up[rr][e] + w4[1][e] * up[rr + 1][e] + w4[2][e] * up[rr + 2][e] + w4[3][e] * up[rr + 3][e]);
            *(LAS f16x8*)(lds + XC_OFF + lb + rr * XC_STRIDE) = h;
        }
    }
    LDS_WAIT(); __syncthreads();
    if (C.flags & 32) return;
    const int c = lane & 15, g = lane >> 4, chl = 16 * wave + c, ch = 128 * j + chl;
    f16x8 Ba[4], Bx[4];
    { const f16* wa = C.WG + ((size_t)(j * 2 + 0) * HB + chl) * HB + 8 * g; const f16* wx = C.WG + ((size_t)(j * 2 + 1) * HB + chl) * HB + 8 * g;
#pragma unroll
        for (int kk = 0; kk < 4; ++kk) { Ba[kk] = *(const f16x8*)(wa + 32 * kk); Bx[kk] = *(const f16x8*)(wx + 32 * kk); } }
    const float ba = C.b_a[ch], bx = C.b_x[ch], nsp = C.nsp[ch], nsl = nsp * LN2;
    float k30 = 30.f, k6 = 1.f / 6.f, k24 = 1.f / 24.f, k120 = 1.f / 120.f, knl = -LOG2E;
    asm volatile("" : "+v"(k30), "+v"(k6), "+v"(k24), "+v"(k120), "+v"(knl));
    const float bla = knl * ba, blx = knl * bx;
    const bool fast = __all(nsl > -0.3f);
    f16x4 AT[16], HT[16];
    float Ac = 1.f, Hc = 0.f;
    const LAS unsigned char* xcrow = lds + XC_OFF + c * XC_STRIDE + 16 * g;
    const LAS unsigned char* xcel = lds + XC_OFF + (4 * g) * XC_STRIDE + 2 * chl;
    LAS unsigned char* sgel = lds + SG_OFF + (4 * g) * XC_STRIDE + 2 * chl;
    f32x4 ga_n = {0.f, 0.f, 0.f, 0.f}, gx_n = {0.f, 0.f, 0.f, 0.f}; f16 xc_n[4];
#define MIX_GATES(RF) { ga_n = (f32x4){0.f, 0.f, 0.f, 0.f}; gx_n = ga_n; \
        _Pragma("unroll") for (int kk = 0; kk < 4; ++kk) { const f16x8 a = *(const LAS f16x8*)(xcrow + (16 * (RF)) * XC_STRIDE + 64 * kk); \
            ga_n = __builtin_amdgcn_mfma_f32_16x16x32_f16(a, Ba[kk], ga_n, 0, 0, 0); gx_n = __builtin_amdgcn_mfma_f32_16x16x32_f16(a, Bx[kk], gx_n, 0, 0, 0); } \
        _Pragma("unroll") for (int e = 0; e < 4; ++e) xc_n[e] = *(const LAS f16*)(xcel + (16 * (RF) + e) * XC_STRIDE); }
    MIX_GATES(0)
#pragma unroll
    for (int rf = 0; rf < 16; ++rf) {
        const f32x4 ga = ga_n, gx = gx_n; const f16 xcv[4] = {xc_n[0], xc_n[1], xc_n[2], xc_n[3]};
        if (rf + 1 < 16) MIX_GATES(rf + 1)
        float a4[4], b4_[4];
        if (fast) {
#pragma unroll
            for (int h = 0; h < 2; ++h) {
                const f32x2 gav = {ga[2 * h], ga[2 * h + 1]}, gxv = {gx[2 * h], gx[2 * h + 1]};
                const f32x2 ta = gav * knl + bla, tx = gxv * knl + blx;
                f32x2 ea, ex; ea.x = fexp2(ta.x); ea.y = fexp2(ta.y); ex.x = fexp2(tx.x); ex.y = fexp2(tx.y);
                ea = ea + 1.f; ex = ex + 1.f;
                f32x2 r, ig; r.x = frcp(ea.x); r.y = frcp(ea.y); ig.x = frcp(ex.x); ig.y = frcp(ex.y);
                const f32x2 y = r * nsl;
                f32x2 d = y * k120 + k24; d = d * y + k6; d = d * y + 0.5f; d = d * y + 1.f; d = d * y;
                const f32x2 av = d + 1.f, m2 = -d * (d + 2.f);
                f32x2 mult; mult.x = __builtin_amdgcn_sqrtf(m2.x); mult.y = __builtin_amdgcn_sqrtf(m2.y);
                if (!SAMPLE) { if (h == 0 && chunk == 0 && rf == 0 && g == 0) mult.x = 1.f; }
                f32x2 xc; xc.x = (float)xcv[2 * h]; xc.y = (float)xcv[2 * h + 1];
                const f32x2 bv = mult * ig * xc;
                a4[2 * h] = av.x; a4[2 * h + 1] = av.y; b4_[2 * h] = bv.x; b4_[2 * h + 1] = bv.y;
            }
        } else {
#pragma unroll
            for (int e = 0; e < 4; ++e) {
                const float r = sigmoidf_(__builtin_amdgcn_fmed3f(ga[e] + ba, -k30, k30)), ig = sigmoidf_(__builtin_amdgcn_fmed3f(gx[e] + bx, -k30, k30));
                const float l2a = r * nsp, x2 = 2.f * LN2 * l2a;
                const float a = fexp2(l2a);
                const float em = x2 * (1.f + x2 * (0.5f + x2 * (k6 + x2 * (k24 + x2 * (k120 + x2 * (k120 * (1.f / 6.f)))))));
                const float m2 = (x2 > -0.3f) ? -em : (1.f - a * a);
                float mult = __builtin_amdgcn_sqrtf(fmaxf(m2, 0.f));
                if (!SAMPLE) { if (chunk == 0 && rf == 0 && g == 0 && e == 0) mult = 1.f; }
                const float xc = (float)xcv[e];
                a4[e] = a; b4_[e] = mult * ig * xc;
            }
        }
        f32x4 Ap, Hp; float Ar = 1.f, Hr = 0.f;
#pragma unroll
        for (int e = 0; e < 4; ++e) { Hr = a4[e] * Hr + b4_[e]; Ar = a4[e] * Ar; Ap[e] = Ar; Hp[e] = Hr; }
        if (SAMPLE) {
            const int b = (pm - 64) * 32 + 2 * rf + (g >> 1);
            float hin = C.st_h[(size_t)b * D + ch];
            const float Apv = __shfl_up(Ar, 16), Hpv = __shfl_up(Hr, 16);
            if (g & 1) hin = Apv * hin + Hpv;
#pragma unroll
            for (int e = 0; e < 4; ++e) { const float h = Ap[e] * hin + Hp[e];
                LAS f16* sg = (LAS f16*)(sgel + (16 * rf + e) * XC_STRIDE); *sg = (f16)(h * (float)*sg);
                if ((g & 1) && e == 3) C.out[O_RS + ((size_t)C.layer * DECB + b) * D + ch] = h; }
        } else {
            float Ai = Ar, Hi = Hr;
            { const float Aq = __shfl_up(Ai, 16), Hq = __shfl_up(Hi, 16); if (g >= 1) { Hi = Ai * Hq + Hi; Ai = Ai * Aq; } }
            { const float Aq = __shfl_up(Ai, 32), Hq = __shfl_up(Hi, 32); if (g >= 2) { Hi = Ai * Hq + Hi; Ai = Ai * Aq; } }
            float Ae = __shfl_up(Ai, 16), He = __shfl_up(Hi, 16); if (g == 0) { Ae = 1.f; He = 0.f; }
            const float Ab = __shfl(Ai, 48 + c), Hb = __shfl(Hi, 48 + c);
            const float Ax = Ae * Ac, Hx = Ae * Hc + He;
#pragma unroll
            for (int e = 0; e < 4; ++e) { AT[rf][e] = (f16)(Ap[e] * Ax); HT[rf][e] = (f16)(Ap[e] * Hx + Hp[e]); }
            asm volatile("" : "+v"(AT[rf]), "+v"(HT[rf]));
            Hc = Ab * Hc + Hb; Ac = Ab * Ac;
        }
    }
    if (C.flags & 128) { asm volatile("" :: "v"(Ac), "v"(Hc), "v"(AT[15]), "v"(HT[7])); return; }
    if (!SAMPLE) {
        unsigned long long* gbase = C.gran + ((size_t)((sq * 8 + chunk) * 8 + j) * HB) * 2;
        if (g == 0 && chunk < 7) {
            __hip_atomic_store(gbase + chl * 2 + 0, ((unsigned long long)epoch << 32) | __float_as_uint(Ac), RLX_AGENT);
            __hip_atomic_store(gbase + chl * 2 + 1, ((unsigned long long)epoch << 32) | __float_as_uint(Hc), RLX_AGENT);
        }
        float Ag = 1.f, Hg = 0.f;
        {
            const unsigned long long* gp0 = C.gran + ((size_t)((sq * 8 + 2 * g) * 8 + j) * HB + chl) * 2;
            const bool n0 = 2 * g < chunk && !(C.flags & 64), n1 = 2 * g + 1 < chunk && !(C.flags & 64);
            unsigned long long xa0 = 0, xh0 = 0, xa1 = 0, xh1 = 0; unsigned spins = 0;
            for (;;) {
                bool ok = true;
                if (n0) { xa0 = __hip_atomic_load(gp0, RLX_AGENT); xh0 = __hip_atomic_load(gp0 + 1, RLX_AGENT); }
                if (n1) { xa1 = __hip_atomic_load(gp0 + 8 * HB * 2, RLX_AGENT); xh1 = __hip_atomic_load(gp0 + 8 * HB * 2 + 1, RLX_AGENT); }
                if (n0) ok = ok && ((unsigned)(xa0 >> 32) == epoch) && ((unsigned)(xh0 >> 32) == epoch);
                if (n1) ok = ok && ((unsigned)(xa1 >> 32) == epoch) && ((unsigned)(xh1 >> 32) == epoch);
                if (ok) break;
                __builtin_amdgcn_s_sleep(2);
                if (++spins > (1u << 22)) { __hip_atomic_store(C.err, 1u, RLX_AGENT); break; }
            }
            if (n0) { Ag = __uint_as_float((unsigned)xa0); Hg = __uint_as_float((unsigned)xh0); }
            if (n1) { const float a1 = __uint_as_float((unsigned)xa1), h1 = __uint_as_float((unsigned)xh1); Hg = a1 * Hg + h1; Ag = a1 * Ag; }
        }
        { const float Aq = __shfl_up(Ag, 16), Hq = __shfl_up(Hg, 16); if (g >= 1) { Hg = Ag * Hq + Hg; Ag = Ag * Aq; } }
        { const float Aq = __shfl_up(Ag, 32), Hq = __shfl_up(Hg, 32); if (g >= 2) { Hg = Ag * Hq + Hg; Ag = Ag * Aq; } }
        float hin = __shfl(Hg, 48 + c);
        if (!(C.flags & 256))
#pragma unroll
        for (int rf = 0; rf < 16; ++rf)
#pragma unroll
            for (int e = 0; e < 4; ++e) { const float h = (float)AT[rf][e] * hin + (float)HT[rf][e];
                LAS f16* sg = (LAS f16*)(sgel + (16 * rf + e) * XC_STRIDE); *sg = (f16)(h * (float)*sg); }
        if (chunk == 7 && g == 0) C.out[O_RP + ((size_t)C.layer * BATCH + sq) * D + ch] = Ac * hin + Hc;
    }
    LDS_WAIT(); __syncthreads();
    if (!(C.flags & 512)) { const unsigned uo2 = opaque_u(((unsigned)grow0 * 2048u + cb) * 2u); const unsigned lb2 = opaque_u((unsigned)(r0 * XC_STRIDE + 16 * o));
#pragma unroll
    for (int rr = 0; rr < 8; ++rr) st16((char*)C.U + (size_t)(uo2 + (unsigned)(rr * 2048 * 2)), *(const LAS u32x4*)(lds + SG_OFF + lb2 + rr * XC_STRIDE)); }
    LDS_WAIT(); __syncthreads();
}

struct ConvCtx { f16* U; const float *conv3_w, *st_c3; unsigned long long* cgran; unsigned* err; float* out; int layer; };

__device__ __forceinline__ void row_mu_rstd(const float* stats, unsigned row, float& mu, float& rstd) {
    const f32x4 s0 = *(const f32x4*)((const char*)stats + (size_t)(row * 32u)), s1 = *(const f32x4*)((const char*)stats + (size_t)(row * 32u + 16u));
    const float sum = (s0[0] + s0[2]) + (s1[0] + s1[2]), sq = (s0[1] + s0[3]) + (s1[1] + s1[3]);
    mu = sum * (1.f / D); const float var = sq * (1.f / D) - mu * mu; rstd = __builtin_amdgcn_rsqf(var + LN_EPS);
}

__device__ __forceinline__ void rows_mu_rstd(const float* stats, unsigned row0, unsigned lrow, int fq, float (&mu)[2][4], float (&rstd)[2][4]) {
    f32x2 st[2][4];
#pragma unroll
    for (int ai = 0; ai < 2; ++ai)
#pragma unroll
        for (int m = 0; m < 4; ++m) st[ai][m] = *(const f32x2*)((const char*)stats + (size_t)((row0 + lrow + (unsigned)(ai * 128 + m * 16)) * 32u + (unsigned)fq * 8u));
    float invd = 1.f / D; asm volatile("" : "+v"(invd));
#pragma unroll
    for (int ai = 0; ai < 2; ++ai)
#pragma unroll
        for (int m = 0; m < 4; ++m) { float sm = st[ai][m].x, sq = st[ai][m].y;
            sm += __shfl_xor(sm, 16); sq += __shfl_xor(sq, 16); sm += __shfl_xor(sm, 32); sq += __shfl_xor(sq, 32);
            const float u = sm * invd; mu[ai][m] = u; rstd[ai][m] = __builtin_amdgcn_rsqf(sq * invd - u * u + LN_EPS); }
}

struct Epi1 {
    static constexpr bool PERM = true, HAS_MID = false, USES_BAR = false, HAS_DRAIN = true, HAS_PRELOAD = true;
    unsigned char* wsb; const float *c1, *c2, *stats; float* out; int layer; MixCtx mix; ConvCtx cv;
    LAS unsigned char* ldsb; mutable int tab_pm; mutable int ctab;
    __device__ __forceinline__ void row_table(const g8::Unit& u, int wid) const {
        if (u.pm == tab_pm) return;
        tab_pm = u.pm;
        const unsigned t = opaque_u((unsigned)(wid * 64 + lane_id()));
        if (t < 256u) { float mu = 0.f, rstd = 1.f; if (stats) row_mu_rstd(stats, (unsigned)(u.pm * 256) + t, mu, rstd); *(LAS f32x2*)(ldsb + ROWTAB_OFF + 8u * t) = (f32x2){mu, rstd}; }
        LDS_WAIT(); G8_BAR; asm volatile("" ::: "memory");
    }
    __device__ __forceinline__ bool drains(const g8::Unit& u) const { return u.pn < 8; }
    __device__ __forceinline__ void preload(const g8::Unit& u, LAS unsigned char* lds, int wid, int lane, int par) const {
        const float* src = (wid < 4 ? c1 : c2) + u.pn * 256 + (wid & 3) * 64 + lane;
        ctab = C1C2_OFF + par * 2048;
        __builtin_amdgcn_global_load_lds((const unsigned*)src, (LAS unsigned*)(lds + ctab + wid * 256), 4, 0, 0);
    }
    __device__ __forceinline__ void fused(const f32x4 (&acc)[2][2][4][2], const g8::Unit& u, int wr, int wc, int fr, int fq, LAS unsigned char* lds, int wid) const {
        const int j = u.pn & 7;
        const unsigned lcol = opaque_u((unsigned)(wc * 32 + 8 * fq));
        const unsigned lrow = opaque_u((unsigned)(wr * 64 + fr));
        f32x4 c1v[2][2], c2v[2][2];
#pragma unroll
        for (int bj = 0; bj < 2; ++bj)
#pragma unroll
            for (int n = 0; n < 2; ++n) { c1v[bj][n] = *(const LAS f32x4*)(ldsb + ctab + (lcol + bj * 128 + 4 * n) * 4u); c2v[bj][n] = *(const LAS f32x4*)(ldsb + ctab + 1024 + (lcol + bj * 128 + 4 * n) * 4u); }
        const int row0u = u.pm * 256; const bool smp = row0u >= MP;
        const bool isr = true, sil = true;
        const unsigned epoch = (unsigned)layer + 1u;
        row_table(u, wid);
#pragma unroll
        for (int ai = 0; ai < 2; ++ai)
#pragma unroll
            for (int m = 0; m < 4; ++m) {
                const unsigned rl = lrow + (unsigned)(ai * 128 + m * 16);
                const unsigned row = (unsigned)row0u + rl;
                const f32x2 mr = *(const LAS f32x2*)(ldsb + ROWTAB_OFF + 8u * rl); const float mu = mr.x, rstd = mr.y;
                f32x4 z[2][2];
#pragma unroll
                for (int bj = 0; bj < 2; ++bj)
#pragma unroll
                    for (int n = 0; n < 2; ++n) z[bj][n] = (acc[ai][bj][m][n] - mu * c1v[bj][n]) * rstd + c2v[bj][n];
                const unsigned lo = rl * XC_STRIDE + lcol * 2u;
                *(LAS u32x4*)(lds + XC_OFF + lo) = pk8h(z[0][0], z[0][1]);
                f32x4 g0, g1;
#pragma unroll
                for (int e = 0; e < 4; ++e) { const float a0 = z[1][0][e], a1 = z[1][1][e]; g0[e] = sil ? siluf_(a0) : a0; g1[e] = sil ? siluf_(a1) : a1; }
                *(LAS u32x4*)(lds + SG_OFF + lo) = pk8h(g0, g1);
                const int t = smp ? ((row - MP) & 7) : (row & (SEQ - 1)); const int T = smp ? DECS : SEQ; const int sb = smp ? ((row - MP) >> 3) : (row >> 11);
                if (isr && t >= T - 3) { float* dst = out + (smp ? O_C4S : O_C4P) + ((size_t)(layer * (smp ? DECB : BATCH) + sb) * 3 + (t - (T - 3))) * D + 128 * j + lcol;
                    *(f32x4*)dst = z[0][0]; *(f32x4*)(dst + 4) = z[0][1]; }
                if (ai == 1 && m == 3) {
                    if (isr && !smp && (u.pm & 7) < 7 && rl >= 253u) { unsigned long long* hp = mix.hgran + ((size_t)(u.pm * 8 + j) * 3 + (rl - 253u)) * HB + lcol;
#pragma unroll
                        for (int e = 0; e < 4; ++e) { __hip_atomic_store(hp + e, ((unsigned long long)epoch << 32) | __float_as_uint(z[0][0][e]), RLX_AGENT);
                                                      __hip_atomic_store(hp + 4 + e, ((unsigned long long)epoch << 32) | __float_as_uint(z[0][1][e]), RLX_AGENT); } }
                }
            }
        LDS_WAIT(); G8_BAR; asm volatile("" ::: "memory");
        if (smp) rnn_mixer<true>(mix, lds, u.pm, j, wid); else rnn_mixer<false>(mix, lds, u.pm, j, wid);
    }
    template <bool SMP>
    __device__ __forceinline__ void conv_epi(const f32x4 (&acc)[2][2][4][2], const g8::Unit& u, int wr, int wc, int fr_, int fq) const {
        const int k = u.pn - 8, chunk = u.pm & 7;
        const int fr = opaque_v(fr_);
        const unsigned lcol = opaque_u((unsigned)(wc * 32 + 8 * fq));
        const unsigned lrow = opaque_u((unsigned)(wr * 64 + fr));
        const unsigned chl = opaque_u((unsigned)(wc * 16 + 4 * fq));
        const unsigned chg = (unsigned)(64 * k) + chl;
        f32x4 c1v[2][2], c2v[2][2];
#pragma unroll
        for (int bj = 0; bj < 2; ++bj)
#pragma unroll
            for (int n = 0; n < 2; ++n) { c1v[bj][n] = *(const LAS f32x4*)(ldsb + ctab + (lcol + bj * 128 + 4 * n) * 4u); c2v[bj][n] = *(const LAS f32x4*)(ldsb + ctab + 1024 + (lcol + bj * 128 + 4 * n) * 4u); }
        f32x4 w3[3];
#pragma unroll
        for (int kk = 0; kk < 3; ++kk) w3[kk] = *(const f32x4*)((const char*)cv.conv3_w + (size_t)(((unsigned)(kk * D) + chg) * 4u));
        const int row0u = u.pm * 256;
        const unsigned epoch = (unsigned)layer + 1u;
        row_table(u, wr * 4 + wc);
#define CE_ROR(v, n) __int_as_float(__builtin_amdgcn_mov_dpp(__float_as_int(v), 0x120 + (n), 0xf, 0xf, true))
        f32x4 H1[2], H2[2];
        if (!SMP) {
            LAS unsigned char* halo = ldsb + CONV_HALO_OFF;
#pragma unroll
            for (int ai = 0; ai < 2; ++ai) {
                const unsigned rl = lrow + (unsigned)(ai * 128 + 48);
                const f32x2 mr = *(const LAS f32x2*)(ldsb + ROWTAB_OFF + 8u * rl);
                const f32x4 cc = (acc[ai][0][3][1] - mr.x * c1v[0][1]) * mr.y + c2v[0][1], chh = (acc[ai][1][3][1] - mr.x * c1v[1][1]) * mr.y + c2v[1][1];
                const f32x4 pl = cc * chh;
                if (fr >= 14) {
                    *(LAS f32x4*)(halo + (unsigned)(((2 * ai + wr) * 2 + (fr - 14)) * 256) + chl * 4u) = pl;
                    if (ai == 1 && wr == 1) {
                        if (chunk < 7) { unsigned long long* cg = cv.cgran + ((size_t)(u.pm * 16 + k) * 2 + (fr - 14)) * 64 + chl;
#pragma unroll
                            for (int e = 0; e < 4; ++e) __hip_atomic_store(cg + e, ((unsigned long long)epoch << 32) | __float_as_uint(pl[e]), RLX_AGENT); }
                        else *(f32x4*)(out + O_C3P + ((size_t)(layer * BATCH + (u.pm >> 3)) * 2 + (fr - 14)) * D + chg) = pl;
                    }
                }
            }
            LDS_WAIT(); G8_BAR; asm volatile("" ::: "memory");
#pragma unroll
            for (int ai = 0; ai < 2; ++ai) {
                if (ai == 1 || wr == 1) { const unsigned so = (unsigned)(((2 * ai + wr - 1) * 2) * 256) + chl * 4u;
                    H2[ai] = *(const LAS f32x4*)(halo + so); H1[ai] = *(const LAS f32x4*)(halo + so + 256u); }
                else { H1[0] = (f32x4){0.f, 0.f, 0.f, 0.f}; H2[0] = H1[0];
                    if (chunk > 0 && fr < 2) {
                        const unsigned long long* cg = cv.cgran + ((size_t)((u.pm - 1) * 16 + k) * 2) * 64 + chl; unsigned spins = 0;
                        for (;;) { bool ok = true;
#pragma unroll
                            for (int e = 0; e < 4; ++e) { const unsigned long long x2 = __hip_atomic_load(cg + e, RLX_AGENT), x1 = __hip_atomic_load(cg + 64 + e, RLX_AGENT);
                                H2[0][e] = __uint_as_float((unsigned)x2); H1[0][e] = __uint_as_float((unsigned)x1); ok = ok && ((unsigned)(x2 >> 32) == epoch) && ((unsigned)(x1 >> 32) == epoch); }
                            if (ok) break;
                            __builtin_amdgcn_s_sleep(2);
                            if (++spins > (1u << 22)) { __hip_atomic_store(cv.err, 1u, RLX_AGENT); break; } }
                    }
                }
            }
        }
        char* ub = (char*)cv.U + ((size_t)row0u * 2048 + 1024) * 2;
#pragma unroll
        for (int ai = 0; ai < 2; ++ai) {
            f32x4 Pp = {0.f, 0.f, 0.f, 0.f};
#pragma unroll
            for (int m = 0; m < 4; ++m) {
                const unsigned rl = lrow + (unsigned)(ai * 128 + m * 16);
                const f32x2 mr = *(const LAS f32x2*)(ldsb + ROWTAB_OFF + 8u * rl); const float mu = mr.x, rstd = mr.y;
                const f32x4 cb = (acc[ai][0][m][0] - mu * c1v[0][0]) * rstd + c2v[0][0], cc = (acc[ai][0][m][1] - mu * c1v[0][1]) * rstd + c2v[0][1];
                const f32x4 gc = (acc[ai][1][m][0] - mu * c1v[1][0]) * rstd + c2v[1][0], chh = (acc[ai][1][m][1] - mu * c1v[1][1]) * rstd + c2v[1][1];
                const f32x4 pl = cc * chh;
                f32x4 q, pm1, pm2;
#pragma unroll
                for (int e = 0; e < 4; ++e) q[e] = cb[e] * siluf_(gc[e]);
                if (SMP) {
                    const int f7 = fr & 7; const unsigned b = ((unsigned)row0u + rl - (unsigned)MP) >> 3;
                    const f32x4 st0 = *(const f32x4*)((const char*)cv.st_c3 + (size_t)(((b * 2u) * D + chg) * 4u)), st1 = *(const f32x4*)((const char*)cv.st_c3 + (size_t)(((b * 2u + 1u) * D + chg) * 4u));
#pragma unroll
                    for (int e = 0; e < 4; ++e) { const float r1 = CE_ROR(pl[e], 1), r2 = CE_ROR(pl[e], 2); pm1[e] = f7 >= 1 ? r1 : st1[e]; pm2[e] = f7 >= 2 ? r2 : (f7 == 1 ? st1[e] : st0[e]); }
                    if (f7 >= 6) *(f32x4*)(out + O_C3S + ((size_t)(layer * DECB + b) * 2 + (f7 - 6)) * D + chg) = pl;
                } else {
#pragma unroll
                    for (int e = 0; e < 4; ++e) { const float r1 = CE_ROR(pl[e], 1), r2 = CE_ROR(pl[e], 2);
                        const float v1 = m == 0 ? H1[ai][e] : CE_ROR(Pp[e], 1), v2 = m == 0 ? (fr == 1 ? H1[ai][e] : H2[ai][e]) : CE_ROR(Pp[e], 2);
                        pm1[e] = fr >= 1 ? r1 : v1; pm2[e] = fr >= 2 ? r2 : v2; }
                }
                f32x4 v;
#pragma unroll
                for (int e = 0; e < 4; ++e) v[e] = q[e] * (w3[0][e] * pm2[e] + w3[1][e] * pm1[e] + w3[2][e] * pl[e]);
                *(u32x2*)(ub + (size_t)((rl * 2048u + chg) * 2u)) = (u32x2){pk2h(v[0], v[1]), pk2h(v[2], v[3])};
                Pp = pl;
                asm volatile("" ::: "memory");
            }
        }
#undef CE_ROR
    }
    __device__ __forceinline__ void operator()(const f32x4 (&acc)[2][2][4][2], const g8::Unit& u, int wr, int wc, int fr, int fq) const {
        if (u.pn < 24) { if (u.pm * 256 >= MP) conv_epi<true>(acc, u, wr, wc, fr, fq); else conv_epi<false>(acc, u, wr, wc, fr, fq); return; }
        const int type = 3, j = u.pn & 7;
        const unsigned lcol = opaque_u((unsigned)(wc * 32 + 8 * fq));
        const unsigned lrow = opaque_u((unsigned)(wr * 64 + fr));
        f32x4 c1v[2][2], c2v[2][2];
#pragma unroll
        for (int bj = 0; bj < 2; ++bj)
#pragma unroll
            for (int n = 0; n < 2; ++n) { c1v[bj][n] = *(const LAS f32x4*)(ldsb + ctab + (lcol + bj * 128 + 4 * n) * 4u); c2v[bj][n] = *(const LAS f32x4*)(ldsb + ctab + 1024 + (lcol + bj * 128 + 4 * n) * 4u); }
        const size_t ub = ((size_t)u.pm * 256 * D + 128 * j) * 2;
        char* o0 = (char*)wsb + (type == 1 ? WS_Q : type == 2 ? WS_P : WS_GR) + ub;
        char* o1 = (char*)wsb + WS_GC + ub;
        const int row0u = u.pm * 256;
        row_table(u, wr * 4 + wc);
#pragma unroll
        for (int ai = 0; ai < 2; ++ai)
#pragma unroll
            for (int m = 0; m < 4; ++m) {
                const unsigned rl = lrow + (unsigned)(ai * 128 + m * 16);
                const unsigned row = (unsigned)row0u + rl;
                const f32x2 mr = *(const LAS f32x2*)(ldsb + ROWTAB_OFF + 8u * rl); const float mu = mr.x, rstd = mr.y;
                f32x4 z[2][2];
#pragma unroll
                for (int bj = 0; bj < 2; ++bj)
#pragma unroll
                    for (int n = 0; n < 2; ++n) z[bj][n] = (acc[ai][bj][m][n] - mu * c1v[bj][n]) * rstd + c2v[bj][n];
                const unsigned o = (rl * D + lcol) * 2u;
                const bool smp = row >= (unsigned)MP; const int t = smp ? ((row - MP) & 7) : (row & (SEQ - 1)); const int T = smp ? DECS : SEQ; const int sb = smp ? ((row - MP) >> 3) : (row >> 11);
                if (type == 1) {
                    f32x4 q0, q1;
#pragma unroll
                    for (int e = 0; e < 4; ++e) { q0[e] = z[0][0][e] * siluf_(z[1][0][e]); q1[e] = z[0][1][e] * siluf_(z[1][1][e]); }
                    st16(o0 + (size_t)o, pk8h(q0, q1));
                } else if (type == 2) {
                    const f32x4 p0 = z[0][0] * z[1][0], p1 = z[0][1] * z[1][1];
                    st16(o0 + (size_t)o, pk8h(p0, p1));
                    if (t >= T - 2) { float* dst = out + (smp ? O_C3S : O_C3P) + ((size_t)(layer * (smp ? DECB : BATCH) + sb) * 2 + (t - (T - 2))) * D + 128 * j + lcol;
                        *(f32x4*)dst = p0; *(f32x4*)(dst + 4) = p1; }
                } else {
                    const u32x2 qr = pk8q(z[0][0], z[0][1]), qc = pk8q(z[1][0], z[1][1]);
                    st16(o0 + (size_t)o, (u32x4){qr.x, qr.y, qc.x, qc.y});
                }
                asm volatile("" ::: "memory");
            }
    }
};

struct Epi3 {
    static constexpr bool PERM = true, HAS_MID = true, USES_BAR = false, HAS_DRAIN = false, HAS_PRELOAD = false;
    const f16 *GR; f16* M16; const LAS unsigned char* lut;
    __device__ __forceinline__ void mid(f32x4 (&acc)[2][2][4][2], const g8::Unit& u, int wr, int wc, int fr, int fq) const {
        const unsigned lo = opaque_u((unsigned)(((wr * 64 + fr) * D + wc * 32 + 8 * fq) * 2));
        const size_t ub = ((size_t)u.pm * 256 * D + u.pn * 256) * 2;
        const char* gb = (const char*)GR + ub;
        const LAS unsigned char* lt = lut;
#define E3_OFF(i) (lo + (unsigned)(((((i) >> 3) * 128 + (((i) >> 1) & 3) * 16) * D + ((i) & 1) * 128) * 2))
#define E3_SIG(w, k) (*(const LAS float*)(lt + (((w) >> (8 * (k))) & 0xffu) * 4u))
#define E3_INV(w, k) (*(const LAS float*)(lt + 1024 + (((w) >> (8 * (k))) & 0xffu) * 4u))
        u32x4 r0 = *(const u32x4*)(gb + (size_t)E3_OFF(0)), r1 = *(const u32x4*)(gb + (size_t)E3_OFF(1)), r2 = *(const u32x4*)(gb + (size_t)E3_OFF(2)), r3 = *(const u32x4*)(gb + (size_t)E3_OFF(3));
#define E3_MID_STEP(i, RS) { const int ai = (i) >> 3, m = ((i) >> 1) & 3, bj = (i) & 1; const u32x4 cr = RS; \
            if ((i) + 4 < 16) RS = *(const u32x4*)(gb + (size_t)E3_OFF((i) + 4)); \
            _Pragma("unroll") for (int e = 0; e < 4; ++e) { acc[ai][bj][m][0][e] *= E3_SIG(cr.x, e) * E3_INV(cr.z, e); acc[ai][bj][m][1][e] *= E3_SIG(cr.y, e) * E3_INV(cr.w, e); } \
            asm volatile("" ::: "memory"); }
#pragma unroll
        for (int i0 = 0; i0 < 16; i0 += 4) { E3_MID_STEP(i0, r0) E3_MID_STEP(i0 + 1, r1) E3_MID_STEP(i0 + 2, r2) E3_MID_STEP(i0 + 3, r3) }
#undef E3_MID_STEP
    }
    __device__ __forceinline__ void operator()(const f32x4 (&acc)[2][2][4][2], const g8::Unit& u, int wr, int wc, int fr, int fq) const {
        const unsigned lo = opaque_u((unsigned)(((wr * 64 + fr) * D + wc * 32 + 8 * fq) * 2));
        const size_t ub = ((size_t)u.pm * 256 * D + u.pn * 256) * 2;
        const char* gb = (const char*)GR + ub + 8; char* mb = (char*)M16 + ub;
        const LAS unsigned char* lt = lut;
        u32x2 c0 = *(const u32x2*)(gb + (size_t)E3_OFF(0)), c1_ = *(const u32x2*)(gb + (size_t)E3_OFF(1)), c2_ = *(const u32x2*)(gb + (size_t)E3_OFF(2)), c3 = *(const u32x2*)(gb + (size_t)E3_OFF(3));
#define E3_FIN_STEP(i, CS) { const int ai = (i) >> 3, m = ((i) >> 1) & 3, bj = (i) & 1; const u32x2 cc = CS; \
            if ((i) + 4 < 16) CS = *(const u32x2*)(gb + (size_t)E3_OFF((i) + 4)); \
            f32x4 v0, v1; \
            _Pragma("unroll") for (int e = 0; e < 4; ++e) { v0[e] = acc[ai][bj][m][0][e] * E3_SIG(cc.x, e); v1[e] = acc[ai][bj][m][1][e] * E3_SIG(cc.y, e); } \
            st16(mb + (size_t)E3_OFF(i), pk8h(v0, v1)); asm volatile("" ::: "memory"); }
#pragma unroll
        for (int i0 = 0; i0 < 16; i0 += 4) { E3_FIN_STEP(i0, c0) E3_FIN_STEP(i0 + 1, c1_) E3_FIN_STEP(i0 + 2, c2_) E3_FIN_STEP(i0 + 3, c3) }
#undef E3_FIN_STEP
#undef E3_SIG
#undef E3_INV
#undef E3_OFF
    }
};

struct Epi4 {
    static constexpr bool PERM = true, HAS_MID = false, USES_BAR = true, HAS_DRAIN = false, HAS_PRELOAD = false;
    const float* xp; f16* S16; const float* stats_prev; float* stats_out; const float *g_prev, *b_prev; LAS f32x2* tab; int layer;
    __device__ __forceinline__ void operator()(const f32x4 (&acc)[2][2][4][2], const g8::Unit& u, int wr, int wc, int fr, int fq) const {
        const int wid_ = wr * 4 + wc;
        const unsigned lcol = opaque_u((unsigned)(wc * 32 + 8 * fq));
        const unsigned lrow = opaque_u((unsigned)(wr * 64 + fr));
        f32x4 gv[2][2], bv[2][2];
        if (layer > 0) {
            const char* gb = (const char*)(g_prev + u.pn * 256); const char* bb = (const char*)(b_prev + u.pn * 256);
#pragma unroll
            for (int bj = 0; bj < 2; ++bj)
#pragma unroll
                for (int n = 0; n < 2; ++n) { gv[bj][n] = *(const f32x4*)(gb + (size_t)((lcol + bj * 128 + 4 * n) * 4u)); bv[bj][n] = *(const f32x4*)(bb + (size_t)((lcol + bj * 128 + 4 * n) * 4u)); }
        }
        const size_t ue = (size_t)u.pm * 256 * D + u.pn * 256;
        char* s16b = (char*)(S16 + ue);
        const unsigned row0u = (unsigned)(u.pm * 256);
        float mus[2][4], rstds[2][4];
        if (layer > 0) rows_mu_rstd(stats_prev, row0u, lrow, fq, mus, rstds);
#define E4_OE(i) ((lrow + (unsigned)(((i) >> 3) * 128 + (((i) >> 1) & 3) * 16)) * D + lcol + (unsigned)(((i) & 1) * 128))
        float ps = 0.f, pq = 0.f;
#define E4_TAIL(i, X0, X1) { const int ai = (i) >> 3, m = ((i) >> 1) & 3, bj = (i) & 1; const unsigned rl = lrow + (unsigned)(ai * 128 + m * 16); \
            const f32x4 s0 = ALPHA * X0 + acc[ai][bj][m][0], s1 = ALPHA * X1 + acc[ai][bj][m][1]; \
            st16(s16b + (size_t)(E4_OE(i) * 2u), pk8h(s0, s1)); \
            ps += ((s0[0] + s0[1]) + (s0[2] + s0[3])) + ((s1[0] + s1[1]) + (s1[2] + s1[3])); \
            pq += ((s0[0] * s0[0] + s0[1] * s0[1]) + (s0[2] * s0[2] + s0[3] * s0[3])) + ((s1[0] * s1[0] + s1[1] * s1[1]) + (s1[2] * s1[2] + s1[3] * s1[3])); \
            if (bj == 1) { ps += __shfl_xor(ps, 16); ps += __shfl_xor(ps, 32); pq += __shfl_xor(pq, 16); pq += __shfl_xor(pq, 32); \
                if (fq == 0) tab[rl * 4 + wc] = (f32x2){ps, pq}; ps = 0.f; pq = 0.f; } \
            asm volatile("" ::: "memory"); }
        {
            u32x4 h0 = *(const u32x4*)(s16b + (size_t)(E4_OE(0) * 2u)), h1 = *(const u32x4*)(s16b + (size_t)(E4_OE(1) * 2u)), h2 = *(const u32x4*)(s16b + (size_t)(E4_OE(2) * 2u)), h3 = *(const u32x4*)(s16b + (size_t)(E4_OE(3) * 2u));
#define E4_STEP(i, HS) { const u32x4 ch = HS; if ((i) + 4 < 16) HS = *(const u32x4*)(s16b + (size_t)(E4_OE((i) + 4) * 2u)); \
                float sv[8]; unpk8h(ch, sv); f32x4 x0, x1; \
                if (layer > 0) { const float mu = mus[(i) >> 3][((i) >> 1) & 3], rstd = rstds[(i) >> 3][((i) >> 1) & 3]; \
                    _Pragma("unroll") for (int e = 0; e < 4; ++e) { x0[e] = (sv[e] - mu) * rstd * gv[(i) & 1][0][e] + bv[(i) & 1][0][e]; x1[e] = (sv[4 + e] - mu) * rstd * gv[(i) & 1][1][e] + bv[(i) & 1][1][e]; } } \
                else { _Pragma("unroll") for (int e = 0; e < 4; ++e) { x0[e] = sv[e]; x1[e] = sv[4 + e]; } } \
                E4_TAIL(i, x0, x1) }
#pragma unroll
            for (int i0 = 0; i0 < 16; i0 += 4) { E4_STEP(i0, h0) E4_STEP(i0 + 1, h1) E4_STEP(i0 + 2, h2) E4_STEP(i0 + 3, h3) }
#undef E4_STEP
        }
#undef E4_TAIL
#undef E4_OE
        LDS_WAIT(); G8_BAR; asm volatile("" ::: "memory");
        const unsigned t = opaque_u((unsigned)(wid_ * 64 + lane_id()));
        if (t < 256u) { const f32x2 a = tab[t * 4 + 0], b = tab[t * 4 + 1], c = tab[t * 4 + 2], d = tab[t * 4 + 3];
            *(f32x2*)((char*)stats_out + (size_t)((row0u + t) * 32u + (unsigned)u.pn * 8u)) = (f32x2){(a.x + b.x) + (c.x + d.x), (a.y + b.y) + (c.y + d.y)}; }
    }
};

template <int RM, int CN>
__device__ __forceinline__ void small_tile_partial(const f16* A, int lda, const f16* Bt, int ldb, int kbeg, int ksteps, LAS unsigned char* lds, int wave, int lane) {
    const int r = lane & 15, q = lane >> 4;
    const f16* ap = A + (size_t)r * lda + kbeg + 8 * q;
    const f16* bp = Bt + (size_t)r * ldb + kbeg + 8 * q;
    f32x4 acc[RM][CN];
#pragma unroll
    for (int i = 0; i < RM; ++i)
#pragma unroll
        for (int j = 0; j < CN; ++j) acc[i][j] = (f32x4){0.f, 0.f, 0.f, 0.f};
#pragma unroll 4
    for (int s = 0; s < ksteps; ++s) {
        f16x8 af[RM], bf[CN];
#pragma unroll
        for (int i = 0; i < RM; ++i) af[i] = *(const f16x8*)(ap + (size_t)(16 * i) * lda + 32 * s);
#pragma unroll
        for (int j = 0; j < CN; ++j) bf[j] = *(const f16x8*)(bp + (size_t)(16 * j) * ldb + 32 * s);
#pragma unroll
        for (int i = 0; i < RM; ++i)
#pragma unroll
            for (int j = 0; j < CN; ++j) acc[i][j] = __builtin_amdgcn_mfma_f32_16x16x32_f16(af[i], bf[j], acc[i][j], 0, 0, 0);
    }
    constexpr int COLS = 16 * CN, ROWS = 16 * RM;
    LAS float* P = (LAS float*)lds + (size_t)wave * ROWS * COLS;
#pragma unroll
    for (int i = 0; i < RM; ++i)
#pragma unroll
        for (int j = 0; j < CN; ++j)
#pragma unroll
            for (int e = 0; e < 4; ++e) P[(16 * i + 4 * q + e) * COLS + 16 * j + r] = acc[i][j][e];
}
template <int ROWS, int COLS>
__device__ __forceinline__ void small_tile_sum(const LAS unsigned char* lds, int w0, int w1, int row, int c8, float (&v)[8]) {
#pragma unroll
    for (int e = 0; e < 8; ++e) v[e] = 0.f;
    for (int w = w0; w < w1; ++w) { const LAS f32x4* p = (const LAS f32x4*)((const LAS float*)lds + ((size_t)w * ROWS + row) * COLS + c8); const f32x4 a = p[0], b = p[1];
#pragma unroll
        for (int e = 0; e < 4; ++e) { v[e] += a[e]; v[4 + e] += b[e]; } }
}

#define XB_TMO      128
#define XB_XCNT(j)  (256  + 64 * (j))
#define XB_XSUB(j)  (1280 + 64 * (j))
#define XB_XGEN(j)  (2304 + 64 * (j))
#define XB_TOP      3328
#define XB_TOPGEN   3392
#define XCD_BAR_WORDS 3456
#define XB_SPIN_CAP (1u << 20)
__device__ __forceinline__ unsigned xb_ld(unsigned* p)              { return __hip_atomic_load(p, __ATOMIC_RELAXED, __HIP_MEMORY_SCOPE_AGENT); }
__device__ __forceinline__ unsigned xb_add(unsigned* p, unsigned v) { return __hip_atomic_fetch_add(p, v, __ATOMIC_RELAXED, __HIP_MEMORY_SCOPE_AGENT); }
__device__ __forceinline__ unsigned xb_xcc_id() { return (unsigned)__builtin_amdgcn_s_getreg((3 << 11) | 20) & 0xFu; }
#define XB_SPIN(cond, bar) do { unsigned _sp = 0; while (cond) { __builtin_amdgcn_s_sleep(1); \
    if ((++_sp & 255u) == 0u) { if (xb_ld(&(bar)[XB_TMO])) break; if (_sp > XB_SPIN_CAP) { atomicAdd(&(bar)[XB_TMO], 1u); break; } } } } while (0)
struct XcdBarrier { unsigned* bar; unsigned x; volatile LAS unsigned* st; };
__device__ __forceinline__ XcdBarrier xcd_barrier_post(unsigned* bar, volatile LAS unsigned* st, bool t0) {
    XcdBarrier b; b.bar = bar; b.x = xb_xcc_id(); b.st = st;
    if (t0) (void)xb_add(&bar[XB_XCNT(b.x)], 1u);
    return b;
}
__device__ __forceinline__ void xcd_barrier_complete(unsigned* bar, unsigned x, unsigned& nloc, unsigned& nx) {
    const unsigned G = gridDim.x * gridDim.y * gridDim.z;
    unsigned sum, cnt, mine, sp = 0u;
    for (;;) {
        sum = 0u; cnt = 0u; mine = 0u;
#pragma unroll
        for (unsigned j = 0; j < 16; ++j) { const unsigned c = xb_ld(&bar[XB_XCNT(j)]); sum += c; cnt += (c > 0u) ? 1u : 0u; mine = (j == x) ? c : mine; }
        if (sum == G) break;
        __builtin_amdgcn_s_sleep(1);
        if ((++sp & 255u) == 0u) { if (xb_ld(&bar[XB_TMO])) break; if (sp > XB_SPIN_CAP) { atomicAdd(&bar[XB_TMO], 1u); break; } }
    }
    nloc = mine > 0u ? mine : 1u; nx = cnt > 0u ? cnt : 1u;
}
__device__ __forceinline__ void xcd_barrier(const XcdBarrier& b, bool t0) {
    asm volatile("s_waitcnt vmcnt(0)" ::: "memory");
    __syncthreads();
    if (t0) {
        unsigned* bar = b.bar;
        __builtin_amdgcn_s_waitcnt(0);
        unsigned nloc = b.st[0], nx = b.st[1];
        if (nloc == 0u) { xcd_barrier_complete(bar, b.x, nloc, nx); b.st[0] = nloc; b.st[1] = nx; }
        const unsigned old = xb_add(&bar[XB_XSUB(b.x)], 1u);
        const unsigned gen = old / nloc;
        if (old + 1u == (gen + 1u) * nloc) {
            __builtin_amdgcn_fence(__ATOMIC_RELEASE, "agent");
            asm volatile("s_waitcnt vmcnt(0)" ::: "memory");
            const unsigned og = xb_add(&bar[XB_TOP], 1u);
            const unsigned tg = og / nx;
            if (og + 1u == (tg + 1u) * nx) xb_add(&bar[XB_TOPGEN], 1u);
            else XB_SPIN(xb_ld(&bar[XB_TOPGEN]) == tg, bar);
            __builtin_amdgcn_fence(__ATOMIC_ACQUIRE, "agent");
            xb_add(&bar[XB_XGEN(b.x)], 1u);
            asm volatile("s_waitcnt vmcnt(0)" ::: "memory");
        } else {
            XB_SPIN(xb_ld(&bar[XB_XGEN(b.x)]) == gen, bar);
            __builtin_amdgcn_fence(__ATOMIC_ACQUIRE, "agent");
            asm volatile("s_waitcnt vmcnt(0)" ::: "memory");
        }
    }
    __syncthreads();
}

constexpr int PROBE_PH = -1, PROBE_REP = 4, PROBE_FLAGS = 0;
struct Args {
    const float* in[20]; float* out; unsigned char* ws; int ph_lo, ph_hi, flags, pad;
};

struct GainBlk { f32x4 g0, g1, b0, b1; };
__device__ __forceinline__ GainBlk load_gains(const float* gsc, const float* bsh, int k0, int c) {
    GainBlk r; const f32x4 one = {1.f, 1.f, 1.f, 1.f}, zero = {0.f, 0.f, 0.f, 0.f};
    r.g0 = gsc ? *(const f32x4*)(gsc + k0 + 8 * c) : one; r.g1 = gsc ? *(const f32x4*)(gsc + k0 + 8 * c + 4) : one;
    r.b0 = bsh ? *(const f32x4*)(bsh + k0 + 8 * c) : zero; r.b1 = bsh ? *(const f32x4*)(bsh + k0 + 8 * c + 4) : zero;
    return r;
}
__device__ __forceinline__ void transpose_block(LAS float* scr, int lane, int k0, f16* WT, int ldo, const GainBlk& gb, float (&s1)[4], float (&s2)[4]) {
    const int c = lane & 7;
    LDS_WAIT(); asm volatile("" ::: "memory");
    float gk[8], bk[8];
#pragma unroll
    for (int e = 0; e < 4; ++e) { gk[e] = gb.g0[e]; gk[4 + e] = gb.g1[e]; bk[e] = gb.b0[e]; bk[4 + e] = gb.b1[e]; }
#pragma unroll
    for (int j = 0; j < 4; ++j) { const int n = (lane >> 3) + 8 * j; const LAS float* s = scr + (8 * c) * 33 + n;
        f16x8 h;
#pragma unroll
        for (int e = 0; e < 8; ++e) { const float w = s[e * 33]; h[e] = (f16)(w * gk[e]); s1[j] += (float)h[e]; s2[j] += bk[e] * w; }
        *(f16x8*)(WT + (size_t)n * ldo + k0 + 8 * c) = h; }
    LDS_WAIT(); asm volatile("" ::: "memory");
}
template <class F>
__device__ __forceinline__ void transpose_cols32(const float* W, int NKB, int ldw, F colf, f16* WT, int ldo, const float* gsc, const float* bsh,
                                                 float* c1o, float* c2o, const float* badd, LAS float* scr, int lane) {
    float s1[4] = {0.f, 0.f, 0.f, 0.f}, s2[4] = {0.f, 0.f, 0.f, 0.f};
    const float* wp = W + (size_t)(lane >> 3) * ldw + colf(lane & 7);
    LAS float* d0 = scr + (lane >> 3) * 33 + 4 * (lane & 7);
    f32x4 xa[8], xb[8];
#pragma unroll
    for (int i = 0; i < 8; ++i) { xa[i] = __builtin_nontemporal_load((const f32x4*)(wp + (size_t)(8 * i) * ldw)); xb[i] = __builtin_nontemporal_load((const f32x4*)(wp + (size_t)(64 + 8 * i) * ldw)); }
    GainBlk ga = load_gains(gsc, bsh, 0, lane & 7), gb = load_gains(gsc, bsh, 64, lane & 7);
    for (int kb = 0; kb < NKB; kb += 2) {
#pragma unroll
        for (int i = 0; i < 8; ++i) { LAS float* d = d0 + (8 * i) * 33; d[0] = xa[i][0]; d[1] = xa[i][1]; d[2] = xa[i][2]; d[3] = xa[i][3]; }
        const GainBlk gcur = ga;
        if (kb + 2 < NKB) {
            ga = load_gains(gsc, bsh, 64 * (kb + 2), lane & 7);
#pragma unroll
            for (int i = 0; i < 8; ++i) xa[i] = __builtin_nontemporal_load((const f32x4*)(wp + (size_t)(64 * (kb + 2) + 8 * i) * ldw)); }
        transpose_block(scr, lane, 64 * kb, WT, ldo, gcur, s1, s2);
#pragma unroll
        for (int i = 0; i < 8; ++i) { LAS float* d = d0 + (8 * i) * 33; d[0] = xb[i][0]; d[1] = xb[i][1]; d[2] = xb[i][2]; d[3] = xb[i][3]; }
        const GainBlk gcur2 = gb;
        if (kb + 3 < NKB) {
            gb = load_gains(gsc, bsh, 64 * (kb + 3), lane & 7);
#pragma unroll
            for (int i = 0; i < 8; ++i) xb[i] = __builtin_nontemporal_load((const f32x4*)(wp + (size_t)(64 * (kb + 3) + 8 * i) * ldw)); }
        transpose_block(scr, lane, 64 * (kb + 1), WT, ldo, gcur2, s1, s2);
    }
    if (c1o) {
        const int c = lane & 7;
#pragma unroll
        for (int j = 0; j < 4; ++j) { float a = s1[j], b = s2[j];
            a += __shfl_xor(a, 1); a += __shfl_xor(a, 2); a += __shfl_xor(a, 4); b += __shfl_xor(b, 1); b += __shfl_xor(b, 2); b += __shfl_xor(b, 4);
            const int n = (lane >> 3) + 8 * j;
            if (c == 0) { c1o[n] = a; c2o[n] = b + badd[colf(n >> 2) + (n & 3)]; } }
    }
}
template <class F>
__device__ __forceinline__ void transpose_tile256(const float* W, int ldw, F colf, f16* WT, int ldo, const float* gsc, const float* bsh,
                                                  float* c1o, float* c2o, const float* badd, LAS unsigned char* lds, int wave, int lane) {
    LAS float* T = (LAS float*)lds;
    const float* wp = W + (size_t)(wave * 16) * ldw + colf(lane);
    const int c = lane & 15, q = lane >> 4;
    float s1[8], s2[8];
#pragma unroll
    for (int j = 0; j < 8; ++j) { s1[j] = 0.f; s2[j] = 0.f; }
    f32x4 x[16];
#pragma unroll
    for (int i = 0; i < 16; ++i) x[i] = __builtin_nontemporal_load((const f32x4*)(wp + (size_t)i * ldw));
    const unsigned wbase = (unsigned)((wave * 16) * 256 + 32 * (lane >> 3)), wn = (unsigned)(4 * (lane & 7));
    for (int kt = 0; kt < 8; ++kt) {
#pragma unroll
        for (int i = 0; i < 16; ++i) *(LAS f32x4*)(T + wbase + (unsigned)(i * 256) + (wn ^ (unsigned)((((2 * wave + (i >> 3)) & 7) << 2)))) = x[i];
        LDS_WAIT(); __syncthreads();
        const GainBlk gb = load_gains(gsc, bsh, 128 * kt, c);
        if (kt + 1 < 8) {
#pragma unroll
            for (int i = 0; i < 16; ++i) x[i] = __builtin_nontemporal_load((const f32x4*)(wp + (size_t)(128 * (kt + 1) + i) * ldw)); }
        float gk[8], bk[8];
#pragma unroll
        for (int e = 0; e < 4; ++e) { gk[e] = gb.g0[e]; gk[4 + e] = gb.g1[e]; bk[e] = gb.b0[e]; bk[4 + e] = gb.b1[e]; }
#pragma unroll
        for (int j = 0; j < 8; ++j) { const int nl = q + 4 * j; const LAS float* sp = T + (8 * c) * 256 + 32 * wave + (nl ^ ((c & 7) << 2));
            f16x8 h;
#pragma unroll
            for (int e = 0; e < 8; ++e) { const float w = sp[e * 256]; h[e] = (f16)(w * gk[e]); s1[j] += (float)h[e]; s2[j] += bk[e] * w; }
            *(f16x8*)(WT + (size_t)(32 * wave + nl) * ldo + 128 * kt + 8 * c) = h; }
        LDS_WAIT(); __syncthreads();
    }
    if (c1o) {
#pragma unroll
        for (int j = 0; j < 8; ++j) { float a = s1[j], b = s2[j];
#pragma unroll
            for (int o = 1; o < 16; o <<= 1) { a += __shfl_xor(a, o); b += __shfl_xor(b, o); }
            const int n = 32 * wave + q + 4 * j;
            if (c == 0) { c1o[n] = a; c2o[n] = b + badd[colf(n >> 2) + (n & 3)]; } }
    }
}
__device__ __forceinline__ void p0_prologue(const Args& A, LAS unsigned char* lds, int vcu, int G, int wave, int lane) {
    LAS float* scr = (LAS float*)(lds + wave * 16384);
    const int gw = vcu * 8 + wave, NGW = G * 8;
    const float* w_in = A.in[5]; const float* b_in = A.in[6]; const float* ln_g = A.in[18]; const float* ln_b = A.in[19];
    f16* WIN = (f16*)(A.ws + WS_WIN); f16* WRC = (f16*)(A.ws + WS_WRC); f16* WO = (f16*)(A.ws + WS_WO); f16* WG = (f16*)(A.ws + WS_WG);
    float* C1 = (float*)(A.ws + WS_C1); float* C2 = (float*)(A.ws + WS_C2);
    constexpr int I_IN = DEPTH * 256, I_SQ = 3 * DEPTH * 32, I_G = DEPTH * NHEAD * 2 * 4;
    const bool coop = (G == 256);
    if (coop && vcu < 176) {
        const int it = vcu;
        if (it < 128) {
            const int l = it >> 5, pn = it & 31;
            const auto cf = [=](int c4g) { const int b32 = c4g >> 3, bj = b32 >> 2, wcb = b32 & 3, c4 = c4g & 7;
                if (pn < 8) return (bj ? 1 : 0) * 1024 + 128 * pn + 32 * wcb + 4 * c4;
                if (pn < 24) return ((c4 & 1) ? (bj == 0 ? 3 : 4) : (bj == 0 ? 2 : 5)) * 1024 + 64 * (pn - 8) + 16 * wcb + 4 * (c4 >> 1);
                return (bj ? 7 : 6) * 1024 + 128 * (pn - 24) + 32 * wcb + 4 * c4; };
            transpose_tile256(w_in + (size_t)l * D * NIN, NIN, cf, WIN + ((size_t)l * NIN + pn * 256) * D, D,
                              l > 0 ? ln_g + (l - 1) * D : nullptr, l > 0 ? ln_b + (l - 1) * D : nullptr,
                              C1 + l * NIN + pn * 256, C2 + l * NIN + pn * 256, b_in + (size_t)l * NIN, lds, wave, lane);
        } else {
            const int r = it - 128, mat = r >> 4, l = (r >> 2) & 3, nb = r & 3;
            const float* W = A.in[15 + mat] + (size_t)l * D * D;
            const auto cf = [=](int c4g) { return nb * 256 + 4 * c4g; };
            if (mat < 2) transpose_tile256(W, D, cf, WRC + ((size_t)l * D + nb * 256) * 2048 + mat * 1024, 2048, nullptr, nullptr, nullptr, nullptr, nullptr, lds, wave, lane);
            else transpose_tile256(W, D, cf, WO + ((size_t)l * D + nb * 256) * D, D, nullptr, nullptr, nullptr, nullptr, nullptr, lds, wave, lane);
        }
    }
    const int lgw = coop ? (vcu - 176) * 8 + wave : gw, lng = coop ? 640 : NGW;
    for (int it = gw; it < I_IN + I_SQ && !coop; it += NGW) {
        if (it < I_IN) {
            const int l = it >> 8, rb = it & 255, rho0 = rb * 32, pn = rho0 >> 8, bj = (rho0 >> 7) & 1, i0 = rho0 & 127;
            int cA, cB, st;
            if (pn < 8) { cA = (bj ? 1 : 0) * 1024 + 128 * pn + i0; cB = cA + 4; st = 8; }
            else if (pn < 24) { const int k = pn - 8, wcb = i0 >> 5; cA = (bj == 0 ? 2 : 5) * 1024 + 64 * k + 16 * wcb; cB = (bj == 0 ? 3 : 4) * 1024 + 64 * k + 16 * wcb; st = 4; }
            else { cA = (bj ? 7 : 6) * 1024 + 128 * (pn - 24) + i0; cB = cA + 4; st = 8; }
            transpose_cols32(w_in + (size_t)l * D * NIN, 16, NIN, [=](int c4) { return ((c4 & 1) ? cB : cA) + st * (c4 >> 1); }, WIN + ((size_t)l * NIN + rho0) * D, D,
                             l > 0 ? ln_g + (l - 1) * D : nullptr, l > 0 ? ln_b + (l - 1) * D : nullptr,
                             C1 + l * NIN + rho0, C2 + l * NIN + rho0, b_in + (size_t)l * NIN, scr, lane);
        } else {
            const int r = it - I_IN, mat = r / (DEPTH * 32), l = (r / 32) % DEPTH, nb = r & 31;
            const float* W = A.in[15 + mat] + (size_t)l * D * D;
            if (mat < 2) transpose_cols32(W, 16, D, [=](int c4) { return nb * 32 + 4 * c4; }, WRC + ((size_t)l * D + nb * 32) * 2048 + mat * 1024, 2048, nullptr, nullptr, nullptr, nullptr, nullptr, scr, lane);
            else transpose_cols32(W, 16, D, [=](int c4) { return nb * 32 + 4 * c4; }, WO + ((size_t)l * D + nb * 32) * D, D, nullptr, nullptr, nullptr, nullptr, nullptr, scr, lane);
        }
    }
    for (int it = lgw; it < I_G && lgw >= 0; it += lng) {
        const int nb = it & 3, which = (it >> 2) & 1, j = (it >> 3) & 7, l = it >> 6;
        const float* W = A.in[which ? 11 : 9] + ((size_t)(l * NHEAD + j)) * HB * HB;
        transpose_cols32(W, 2, HB, [=](int c4) { return nb * 32 + 4 * c4; }, WG + ((size_t)((l * NHEAD + j) * 2 + which) * HB + nb * 32) * HB, HB, nullptr, nullptr, nullptr, nullptr, nullptr, scr, lane);
    }
    f16* X16 = (f16*)(A.ws + WS_S16);
    for (int m0 = lgw; m0 < M && lgw >= 0; m0 += 4 * lng) {
        f32x4 v[4][4];
#pragma unroll
        for (int r = 0; r < 4; ++r) { const int m = m0 + r * lng; if (m < M) { const float* xr = (m < MP) ? A.in[0] + (size_t)m * D : A.in[1] + (size_t)(m - MP) * D;
#pragma unroll
            for (int jj = 0; jj < 4; ++jj) v[r][jj] = __builtin_nontemporal_load((const f32x4*)(xr + 4 * lane + 256 * jj)); } }
#pragma unroll
        for (int r = 0; r < 4; ++r) { const int m = m0 + r * lng; if (m < M) {
#pragma unroll
            for (int jj = 0; jj < 4; ++jj) { u32x2 w; w.x = pk2h(v[r][jj][0], v[r][jj][1]); w.y = pk2h(v[r][jj][2], v[r][jj][3]); *(u32x2*)(X16 + (size_t)m * D + 4 * lane + 256 * jj) = w; } } }
    }
    { constexpr unsigned n16 = (unsigned)((WS_CGRAN + (size_t)64 * 16 * 2 * 64 * 8 - WS_GRAN) / 16);
      u32x4 zv = (u32x4){0u, 0u, 0u, 0u}; asm volatile("" : "+v"(zv));
      for (unsigned i = (unsigned)(gw * 64 + lane); i < n16; i += (unsigned)(NGW * 64)) *(u32x4*)(A.ws + WS_GRAN + (size_t)(i * 16u)) = zv; }
    float* NSP = (float*)(A.ws + WS_NSP);
    for (int i = gw * 64 + lane; i < DEPTH * D; i += NGW * 64) { const float lam = A.in[13][i];
        const float t = fexp2(-LOG2E * fmaxf(lam, -80.f));
        const float sp_small = t * (1.f - t * (0.5f - t * (1.f / 3.f - t * (0.25f - t * 0.2f))));
        const float sp_big = LN2 * __builtin_amdgcn_logf(1.f + t);
        NSP[i] = -8.f * LOG2E * (t < 0.125f ? sp_small : sp_big); }
}

__global__ void __launch_bounds__(512, 2) hawk_fwd(Args args) {
    extern __shared__ __attribute__((aligned(16))) unsigned char lds_raw[];
    LAS unsigned char* lds = (LAS unsigned char*)lds_raw;
    const int wave_s0 = __builtin_amdgcn_readfirstlane(threadIdx.x >> 6);
    const int G = gridDim.x, bx0 = blockIdx.x, vcu0 = (G % 8 == 0) ? (bx0 % 8) * (G / 8) + bx0 / 8 : bx0;
    unsigned* ctl = (unsigned*)(args.ws + WS_CTL);
    volatile LAS unsigned* MISC = (volatile LAS unsigned*)(lds + MISC_OFF);
    if (wave_s0 == 0) MISC[lane_id()] = 0u;
    __syncthreads();
    XcdBarrier bar = xcd_barrier_post(ctl + CW_BAR, MISC + 8, wave_s0 == 0 && lane_id() == 0);
    const int lo = args.ph_lo, hi = args.ph_hi;
    for (int ph = lo; ph < hi; ++ph) {
        const int l = (ph - 1) / 3, k = (ph - 1) % 3;
        unsigned char* ws = (unsigned char*)(GAS unsigned char*)opaque_s64((unsigned long long)args.ws);
        const int wave_s = opaque_s(wave_s0), bx = opaque_s(bx0), vcu = opaque_s(vcu0);
        {
        f16* S16 = (f16*)(ws + WS_S16); f16* Qb = (f16*)(ws + WS_Q); f16* Pb = (f16*)(ws + WS_P);
        f16* GR = (f16*)(ws + WS_GR); f16* GC = (f16*)(ws + WS_GC); f16* U = (f16*)(ws + WS_U); f16* M16 = (f16*)(ws + WS_M16);
        float* STATS = (float*)(ws + WS_STATS);
        float* out = args.out;
        const float* stats_prev = (l > 0) ? STATS + (size_t)((l - 1) & 1) * M * 8 : nullptr;
        float* stats_cur = STATS + (size_t)(l & 1) * M * 8;
        if (ph == 0) {
            p0_prologue(args, lds, vcu, G, wave_s, opaque_v(lane_id()));
        } else if (ph == 1 + 3 * DEPTH) {
            const float* st = STATS + (size_t)((DEPTH - 1) & 1) * M * 8; const float* gg = (const float*)(GAS const float*)opaque_s64((unsigned long long)(args.in[18] + (size_t)(DEPTH - 1) * D)); const float* bb = (const float*)(GAS const float*)opaque_s64((unsigned long long)(args.in[19] + (size_t)(DEPTH - 1) * D));
            const int lane = opaque_v(lane_id()), wave = wave_s;
            const int gw = vcu * 8 + wave, NGW = G * 8;
            f32x4 gv[4], bv[4];
#pragma unroll
            for (int jj = 0; jj < 4; ++jj) { gv[jj] = *(const f32x4*)(gg + 8 * lane + 512 * (jj >> 1) + 4 * (jj & 1)); bv[jj] = *(const f32x4*)(bb + 8 * lane + 512 * (jj >> 1) + 4 * (jj & 1)); }
#define P5_LOAD(r, m) { sa[r] = *(const f32x4*)((const char*)st + (size_t)((unsigned)(m) * 32u)); sb[r] = *(const f32x4*)((const char*)st + (size_t)((unsigned)(m) * 32u + 16u)); \
                hv[r][0] = *(const u32x4*)(S16 + (size_t)(m) * D + 8 * lane); hv[r][1] = *(const u32x4*)(S16 + (size_t)(m) * D + 512 + 8 * lane); }
#define P5_ROW(r, m) { const float sum = (sa[r][0] + sa[r][2]) + (sb[r][0] + sb[r][2]), sq = (sa[r][1] + sa[r][3]) + (sb[r][1] + sb[r][3]); \
                const float mu = sum * (1.f / D), var = sq * (1.f / D) - mu * mu, rstd = __builtin_amdgcn_rsqf(var + LN_EPS); \
                float* yr = out + O_Y + (size_t)(m) * D; \
                _Pragma("unroll") for (int h = 0; h < 2; ++h) { float sv[8]; unpk8h(hv[r][h], sv); f32x4 y0, y1; \
                    _Pragma("unroll") for (int e = 0; e < 4; ++e) { y0[e] = (sv[e] - mu) * rstd * gv[2 * h][e] + bv[2 * h][e]; y1[e] = (sv[4 + e] - mu) * rstd * gv[2 * h + 1][e] + bv[2 * h + 1][e]; } \
                    __builtin_nontemporal_store(y0, (f32x4*)(yr + 512 * h + 8 * lane)); __builtin_nontemporal_store(y1, (f32x4*)(yr + 512 * h + 8 * lane + 4)); } }
            int m0 = gw;
            for (; m0 + NGW < M; m0 += 2 * NGW) { f32x4 sa[2], sb[2]; u32x4 hv[2][2]; P5_LOAD(0, m0) P5_LOAD(1, m0 + NGW) P5_ROW(0, m0) P5_ROW(1, m0 + NGW) }
            if (m0 < M) { f32x4 sa[1], sb[1]; u32x4 hv[1][2]; P5_LOAD(0, m0) P5_ROW(0, m0) }
#undef P5_LOAD
#undef P5_ROW
        } else if (k == 0) {
            g8::Gemm gm{S16, (const f16*)(ws + WS_WIN) + (size_t)l * NIN * D, M, NIN, D}; g8::StaticOrder S; S.init(M, NIN, G, bx); if (G == 256) S.mode = 1;
            Epi1 E{ws, (const float*)(ws + WS_C1) + l * NIN, (const float*)(ws + WS_C2) + l * NIN, stats_prev, out, l,
                   MixCtx{U, (const f16*)(ws + WS_WG) + (size_t)l * NHEAD * 2 * HB * HB,
                          args.in[7] + (size_t)l * 4 * D, args.in[8] + (size_t)l * D, args.in[10] + (size_t)l * D, args.in[12] + (size_t)l * D, (const float*)(ws + WS_NSP) + l * D,
                          args.in[2] + (size_t)l * DECB * D, args.in[3] + (size_t)l * DECB * 3 * D,
                          (unsigned long long*)(ws + WS_GRAN), (unsigned long long*)(ws + WS_HGRAN), (unsigned*)(ws + WS_CTL) + CW_ERR, out, l, args.flags},
                   ConvCtx{U, args.in[14] + (size_t)l * 3 * D, args.in[4] + (size_t)l * DECB * 2 * D, (unsigned long long*)(ws + WS_CGRAN), (unsigned*)(ws + WS_CTL) + CW_ERR, out, l}, lds, -1, C1C2_OFF};
            g8::gemm_phase<Epi1>(lds, gm, S, E, wave_s, args.flags);
        } else if (k == 1) {
            const f16* WRCl = (const f16*)(ws + WS_WRC) + (size_t)l * D * 2048;
            {
                g8::Gemm gm{U, WRCl, MP, D, 2048}; g8::StaticOrder S; S.init(MP, D, G, bx);
                { const int t = wave_s * 64 + opaque_v(lane_id()); if (t < 256) { const float gq = __builtin_amdgcn_fmed3f(__builtin_amdgcn_cvt_f32_fp8(t, 0), -30.f, 30.f), ie = 1.f + fexp2(-LOG2E * gq);
                    *(LAS float*)(lds + TAB_OFF + 4 * t) = frcp(ie); *(LAS float*)(lds + TAB_OFF + 1024 + 4 * t) = ie; } }
                LDS_WAIT(); __syncthreads();
                Epi3 E{GR, M16, lds + TAB_OFF};
                g8::gemm_phase<Epi3>(lds, gm, S, E, wave_s, args.flags);
            }
            for (int tile = bx; tile < 256 && !(args.flags & 4); tile += G) {
                const int lane = opaque_v(lane_id());
                const int row0 = MP + 64 * (tile >> 4), col0 = 64 * (tile & 15);
                small_tile_partial<4, 4>(U + (size_t)row0 * 2048, 2048, WRCl + (size_t)col0 * 2048, 2048, 256 * wave_s, 8, lds, wave_s, lane);
                LDS_WAIT(); __syncthreads();
                const int t = wave_s * 64 + lane, row = t >> 3, c8 = (t & 7) * 8;
                float yr[8], yc[8]; small_tile_sum<64, 64>(lds, 0, 4, row, c8, yr); small_tile_sum<64, 64>(lds, 4, 8, row, c8, yc);
                const size_t o = (size_t)(row0 + row) * D + col0 + c8;
                const u32x4 gw = *(const u32x4*)(GR + o);
                f32x4 v0, v1;
#define ST_SIG(w, k) (*(const LAS float*)(lds + TAB_OFF + (((w) >> (8 * (k))) & 0xffu) * 4u))
#pragma unroll
                for (int e = 0; e < 4; ++e) { v0[e] = ST_SIG(gw.x, e) * yr[e] + ST_SIG(gw.z, e) * yc[e]; v1[e] = ST_SIG(gw.y, e) * yr[4 + e] + ST_SIG(gw.w, e) * yc[4 + e]; }
#undef ST_SIG
                st16(M16 + o, pk8h(v0, v1));
                LDS_WAIT(); __syncthreads();
            }
        } else {
            const f16* WOl = (const f16*)(ws + WS_WO) + (size_t)l * D * D;
            const float* g_prev = l > 0 ? args.in[18] + (size_t)(l - 1) * D : nullptr; const float* b_prev = l > 0 ? args.in[19] + (size_t)(l - 1) * D : nullptr;
            {
                g8::Gemm gm{M16, WOl, MP, D, D}; g8::StaticOrder S; S.init(MP, D, G, bx);
                Epi4 E{args.in[0], S16, stats_prev, stats_cur, g_prev, b_prev, (LAS f32x2*)(lds + TAB_OFF), l};
                g8::gemm_phase<Epi4>(lds, gm, S, E, wave_s, args.flags);
            }
            for (int tile = bx; tile < 256 && !(args.flags & 4); tile += G) {
                const int lane = opaque_v(lane_id());
                const int row0 = MP + 16 * (tile >> 2), tc = tile & 3, col0 = 256 * tc;
                small_tile_partial<1, 16>(M16 + (size_t)row0 * D, D, WOl + (size_t)col0 * D, D, 128 * wave_s, 4, lds, wave_s, lane);
                LDS_WAIT(); __syncthreads();
                const int t = wave_s * 64 + lane, row = t >> 5, c8 = (t & 31) * 8, grow = row0 + row, col = col0 + c8;
                float a8[8]; small_tile_sum<16, 256>(lds, 0, 8, row, c8, a8);
                float x8[8];
                if (l > 0) { float mu, rstd; row_mu_rstd(stats_prev, (unsigned)grow, mu, rstd); float sv[8]; unpk8h(*(const u32x4*)(S16 + (size_t)grow * D + col), sv);
                    const f32x4 g0 = *(const f32x4*)(g_prev + col), g1 = *(const f32x4*)(g_prev + col + 4), b0 = *(const f32x4*)(b_prev + col), b1 = *(const f32x4*)(b_prev + col + 4);
#pragma unroll
                    for (int e = 0; e < 4; ++e) { x8[e] = (sv[e] - mu) * rstd * g0[e] + b0[e]; x8[4 + e] = (sv[4 + e] - mu) * rstd * g1[e] + b1[e]; } }
                else unpk8h(*(const u32x4*)(S16 + (size_t)grow * D + col), x8);
                f32x4 s0, s1; float ps = 0.f, pq = 0.f;
#pragma unroll
                for (int e = 0; e < 4; ++e) { s0[e] = ALPHA * x8[e] + a8[e]; s1[e] = ALPHA * x8[4 + e] + a8[4 + e]; ps += s0[e] + s1[e]; pq += s0[e] * s0[e] + s1[e] * s1[e]; }
                st16(S16 + (size_t)grow * D + col, pk8h(s0, s1));
#pragma unroll
                for (int o = 1; o < 32; o <<= 1) { ps += __shfl_xor(ps, o); pq += __shfl_xor(pq, o); }
                if ((t & 31) == 0) *(f32x2*)(stats_cur + (size_t)grow * 8 + tc * 2) = (f32x2){ps, pq};
                LDS_WAIT(); __syncthreads();
            }
        }
        if (ph + 1 < hi) xcd_barrier(bar, wave_s == 0 && lane_id() == 0);
        }
    }
}

extern "C" void kernel_launch(void* const* d_in, const int* in_sizes, int n_in, void* d_out, int out_size, void* d_ws, size_t ws_size, hipStream_t stream) {
    static int grid = 0;
    if (grid == 0) {
        if (n_in != 20 || (size_t)out_size != O_END || ws_size < WS_END) { fprintf(stderr, "kernel_launch: unexpected shapes: n_in %d out %d ws %zu (need %zu)\n", n_in, out_size, ws_size, (size_t)WS_END); grid = -1; return; }
        int dev = 0, cus = 0, per_cu = 0;
        if (hipGetDevice(&dev) != hipSuccess || hipDeviceGetAttribute(&cus, hipDeviceAttributeMultiprocessorCount, dev) != hipSuccess) { grid = -1; return; }
        if (hipFuncSetAttribute((const void*)hawk_fwd, hipFuncAttributeMaxDynamicSharedMemorySize, LDS_BYTES) != hipSuccess) { fprintf(stderr, "kernel_launch: hipFuncSetAttribute failed\n"); grid = -1; return; }
        if (hipOccupancyMaxActiveBlocksPerMultiprocessor(&per_cu, (const void*)hawk_fwd, 512, LDS_BYTES) != hipSuccess || per_cu < 1) { fprintf(stderr, "kernel_launch: occupancy query failed (%d)\n", per_cu); (void)hipGetLastError(); grid = -1; return; }
        grid = cus;
    }
    if (grid < 0) return;
    (void)hipMemsetAsync((char*)d_ws + WS_CTL, 0, WS_GRAN, stream);
    Args a{};
    for (int i = 0; i < 20; ++i) a.in[i] = (const float*)d_in[i];
    a.out = (float*)d_out; a.ws = (unsigned char*)d_ws;
    const int NPH = 2 + 3 * DEPTH;
    int cuts[PROBE_REP + 4]; int nc = 0;
    cuts[nc++] = 0;
    if (PROBE_PH >= 0) { cuts[nc++] = PROBE_PH + 1; for (int r = 0; r < PROBE_REP; ++r) cuts[nc++] = -(PROBE_PH + 1); if (PROBE_FLAGS) cuts[nc++] = -(PROBE_PH + 1) - 1000; }
    cuts[nc++] = NPH;
    int lo = 0;
    for (int i = 1; i < nc; ++i) {
        int hi = cuts[i]; a.flags = 0; if (hi < -1000) { hi += 1000; lo = -hi - 1; hi = -hi; } else if (hi < 0) { lo = -hi - 1; hi = -hi; a.flags = PROBE_FLAGS; }
        a.ph_lo = lo; a.ph_hi = hi;
        if (i > 1) (void)hipMemsetAsync((char*)d_ws + WS_CTL + CW_BAR * 4, 0, XCD_BAR_WORDS * 4, stream);
        void* params[] = {&a};
        hipError_t e = hipLaunchCooperativeKernel((const void*)hawk_fwd, dim3(grid), dim3(512), params, LDS_BYTES, stream);
        if (e != hipSuccess) { fprintf(stderr, "kernel_launch: cooperative launch failed: %s (grid %d)\n", hipGetErrorString(e), grid); break; }
        lo = hi;
    }
}
```

```cpp
#include <hip/hip_runtime.h>
#include <cstdio>
#include <cstdint>

#define LAS __attribute__((address_space(3)))
#define GAS __attribute__((address_space(1)))
typedef _Float16 f16;
typedef _Float16 f16x8 __attribute__((ext_vector_type(8)));
typedef _Float16 f16x4 __attribute__((ext_vector_type(4)));
typedef _Float16 f16x2 __attribute__((ext_vector_type(2)));
typedef float f32x4 __attribute__((ext_vector_type(4)));
typedef float f32x2 __attribute__((ext_vector_type(2)));
typedef unsigned u32x4 __attribute__((ext_vector_type(4)));
typedef unsigned u32x2 __attribute__((ext_vector_type(2)));

constexpr int D = 1024, NIN = 8192, DEPTH = 4, NHEAD = 8, HB = 128;
constexpr int BATCH = 8, SEQ = 2048, DECB = 128, DECS = 8;
constexpr int MP = BATCH * SEQ, MS = DECB * DECS, M = MP + MS;
constexpr int NRT = M / 256;
constexpr float LN_EPS = 1e-5f;
constexpr float ALPHA = 1.681792830507429f;
constexpr float LOG2E = 1.4426950408889634f, LN2 = 0.6931471805599453f;
constexpr size_t O_Y = 0;
constexpr size_t O_RP = (size_t)M * D;
constexpr size_t O_C4P = O_RP + (size_t)DEPTH * BATCH * D;
constexpr size_t O_C3P = O_C4P + (size_t)DEPTH * BATCH * 3 * D;
constexpr size_t O_RS = O_C3P + (size_t)DEPTH * BATCH * 2 * D;
constexpr size_t O_C4S = O_RS + (size_t)DEPTH * DECB * D;
constexpr size_t O_C3S = O_C4S + (size_t)DEPTH * DECB * 3 * D;
constexpr size_t O_END = O_C3S + (size_t)DEPTH * DECB * 2 * D;

constexpr size_t MiB = 1u << 20;
constexpr size_t WS_CTL = 0, CTL_ZERO_BYTES = 4 * MiB;
constexpr size_t WS_GRAN = 64 * 1024;
constexpr size_t WS_HGRAN = 1280 * 1024;
constexpr size_t WS_CGRAN = 2880 * 1024;
constexpr size_t WS_C1 = 4 * MiB;
constexpr size_t WS_C2 = WS_C1 + 128 * 1024;
constexpr size_t WS_NSP = WS_C2 + 128 * 1024;
constexpr size_t WS_STATS = 5 * MiB;
constexpr size_t WS_SSTAT = 6 * MiB + 512 * 1024;
constexpr size_t WS_WG = 7 * MiB;
constexpr size_t WS_WIN = 10 * MiB;
constexpr size_t WS_WRC = 74 * MiB;
constexpr size_t WS_WO = 90 * MiB;
constexpr size_t ACT = (size_t)M * D * 2;
constexpr size_t WS_S16 = 98 * MiB;
constexpr size_t WS_XR = WS_S16 + ACT, WS_SGR = WS_XR + ACT, WS_Q = WS_SGR + ACT, WS_P = WS_Q + ACT, WS_GR = WS_P + ACT, WS_GC = WS_GR + ACT;
constexpr size_t WS_U = WS_GC + ACT;
constexpr size_t WS_M16 = WS_XR;
constexpr size_t WS_END = WS_U + 2 * ACT;
constexpr int CW_ERR = 0;
constexpr int CW_BAR = 1024;

constexpr int RING_BYTES = 131072;
constexpr int TAB_OFF = RING_BYTES;
constexpr int LDS_BYTES = 149504;
constexpr int MISC_OFF = LDS_BYTES - 256;
constexpr int XC_STRIDE = 272;
constexpr int XC_OFF = 0, SG_OFF = 256 * XC_STRIDE;
constexpr int ROWTAB_OFF = SG_OFF + 256 * XC_STRIDE;
constexpr int LUT_OFF = ROWTAB_OFF;
constexpr int CONV_HALO_OFF = ROWTAB_OFF + 2048;
constexpr int PF_DUMP_OFF = CONV_HALO_OFF;
constexpr int C1C2_OFF = CONV_HALO_OFF + 2048;
static_assert(C1C2_OFF + 4096 <= MISC_OFF, "P2 LDS");

#define RLX_AGENT __ATOMIC_RELAXED, __HIP_MEMORY_SCOPE_AGENT
#define LDS_WAIT() asm volatile("s_waitcnt lgkmcnt(0)" ::: "memory")
#define VM_WAIT() asm volatile("s_waitcnt vmcnt(0)" ::: "memory")

__device__ __forceinline__ int lane_id() { unsigned z = 0u; asm volatile("" : "+v"(z)); return (int)__builtin_amdgcn_mbcnt_hi(~0u, __builtin_amdgcn_mbcnt_lo(~0u, z)); }
namespace g8 {
__device__ __forceinline__ int opq(int x) { asm volatile("" : "+v"(x)); return x; }
constexpr int BM = 256, BK = 64, HALF = 128, HTB = HALF * BK * 2, STAGE_BYTES = 8 * HTB, NXCD = 8, WGM = 8;
__host__ __device__ __forceinline__ int lds_byte(int r, int c) { const int st = (r >> 4) * 2 + (c >> 5), rr = r & 15, cc = c & 31, ob = rr * 64 + cc * 2; return st * 1024 + (ob ^ (((ob >> 9) & 1) << 5)); }
__host__ __device__ __forceinline__ void stage_rc(int b, int& R, int& C) { const int st = b / 1024, sb = b % 1024, swz = sb ^ (((sb >> 9) & 1) << 5); R = (st >> 1) * 16 + swz / 64; C = (st & 1) * 32 + (swz % 64) / 2; }
__host__ __device__ __forceinline__ int perm32(int rho) { const int n = rho >> 4, i = rho & 15; return 8 * (i >> 2) + 4 * n + (i & 3); }

struct Unit { int pm, pn; };
struct Gemm { const f16* A; const f16* Bt; int M, N, K; };

struct StaticOrder {
    int nM, nN, nwg, G, c, mode;
    __host__ __device__ void init(int M_, int N_, int G_, int c_) { nM = M_ / BM; nN = N_ / BM; nwg = nM * nN; G = G_; c = c_; mode = 0; }
    __host__ __device__ bool next(int i, Unit& u) const {
        if (mode == 1) {
            const int x = c & 7, j = c >> 3, q = j >> 3, r = j & 7;
            if (i < 8) { const unsigned long long t = q == 0 ? 0x1B0A1A0919000818ull : q == 1 ? 0x1F0D011E0C1D0B1Cull : q == 2 ? 0x12041110030F0E02ull : 0x0717160615140513ull;
                u.pm = 8 * x + r; u.pn = (int)((t >> (8 * i)) & 0xffu); return true; }
            if (i == 8 && q < 2) { const int s_ = q * 8 + r; u.pm = 64 + (s_ & 3); u.pn = x + 8 * (s_ >> 2); return true; }
            return false;
        }
        const long L = (long)i * G + c; if (L >= nwg) return false;
        int wgid = (int)L; { const int q = nwg / NXCD, r = nwg % NXCD, xcd = wgid % NXCD, off = wgid / NXCD; wgid = (xcd < r ? xcd * (q + 1) : r * (q + 1) + (xcd - r) * q) + off; }
        const int nig = WGM * nN, gid = wgid / nig, fm = gid * WGM, gsz = (nM - fm) < WGM ? (nM - fm) : WGM;
        u.pm = fm + ((wgid % nig) % gsz); u.pn = (wgid % nig) / gsz; return true;
    }
};

template <class Epi>
__device__ __forceinline__ void gemm_phase(LAS unsigned char* lds, const Gemm g, const StaticOrder& S, const Epi& E, const int wid, const int flags) {
    const int lane = opq(lane_id()), tid = wid * 64 + lane, wr = wid >> 2, wc = wid & 3, fr = lane & 15, fq = lane >> 4;
    const int K = g.K, nt = K / BK;
    unsigned voffA[2], voffB[2];
#pragma unroll
    for (int i = 0; i < 2; ++i) { int R, C; stage_rc(tid * 16 + i * 8192, R, C); const int Rb = Epi::PERM ? ((R & ~31) + perm32(R & 31)) : R;
        voffA[i] = (unsigned)(R * K + C) * 2u; voffB[i] = (unsigned)(Rb * K + C) * 2u; }
    const size_t kstep = (size_t)(BK * 2);
    const size_t hstep = (size_t)HALF * K * 2;
    const size_t tstep = 2 * hstep;
    const unsigned ldsw = (unsigned)wid * 1024u;
    const int aoff = lds_byte(wr * 64 + fr, fq * 8), boff = lds_byte(wc * 32 + fr, fq * 8);
#define G8_SA(b, h) (((b) * 2 + (h)) * HTB)
#define G8_SB(b, h) ((4 + (b) * 2 + (h)) * HTB)
#define G8_STAGE(bufoff, gbase, voff) do { _Pragma("unroll") for (int _i = 0; _i < 2; ++_i) \
        __builtin_amdgcn_global_load_lds((const unsigned*)((const char*)(gbase) + (voff)[_i]), (LAS unsigned*)(lds + (bufoff) + ldsw + _i * 8192), 16, 0, 0); } while (0)
#define G8_LDA(dst, b, h) do { _Pragma("unroll") for (int m = 0; m < 4; ++m) _Pragma("unroll") for (int k = 0; k < 2; ++k) dst[m][k] = *(const LAS f16x8*)(lds + G8_SA(b, h) + aoff + m * 2048 + k * 1024); } while (0)
#define G8_LDB(dst, b, h) do { _Pragma("unroll") for (int n = 0; n < 2; ++n) _Pragma("unroll") for (int k = 0; k < 2; ++k) dst[n][k] = *(const LAS f16x8*)(lds + G8_SB(b, h) + boff + n * 2048 + k * 1024); } while (0)
#define G8_MMA(ai, bj, At, Bt) do { __builtin_amdgcn_s_setprio(1); _Pragma("unroll") for (int m = 0; m < 4; ++m) _Pragma("unroll") for (int n = 0; n < 2; ++n) _Pragma("unroll") for (int k = 0; k < 2; ++k) \
        acc[ai][bj][m][n] = __builtin_amdgcn_mfma_f32_16x16x32_f16(Bt[n][k], At[m][k], acc[ai][bj][m][n], 0, 0, 0); __builtin_amdgcn_s_setprio(0); } while (0)
#define G8_WAIT_V(n) asm volatile("s_waitcnt vmcnt(" #n ")" ::: "memory")
#define G8_WAIT_L(n) asm volatile("s_waitcnt lgkmcnt(" #n ")" ::: "memory")
#define G8_BAR __builtin_amdgcn_s_barrier()
#define G8_SCHED __builtin_amdgcn_sched_barrier(0)
    Unit cur, nxt; int ui = 0;
    if (!S.next(0, cur)) return;
    const char* cA = (const char*)g.A + (size_t)cur.pm * tstep; const char* cB = (const char*)g.Bt + (size_t)cur.pn * tstep;
    bool pro = true;
    for (;;) {
        f32x4 acc[2][2][4][2];
#pragma unroll
        for (int a = 0; a < 2; ++a)
#pragma unroll
            for (int b = 0; b < 2; ++b)
#pragma unroll
                for (int m = 0; m < 4; ++m)
#pragma unroll
                    for (int n = 0; n < 2; ++n) acc[a][b][m][n] = (f32x4){0.f, 0.f, 0.f, 0.f};
        f16x8 At[4][2], B0[2][2], B1[2][2];
        const bool has_next = S.next(ui + 1, nxt);
        bool drain = false; if constexpr (Epi::HAS_DRAIN) drain = E.drains(cur);
        if (pro) {
            G8_STAGE(G8_SB(0, 0), cB, voffB); G8_STAGE(G8_SB(0, 1), cB + hstep, voffB); G8_STAGE(G8_SA(0, 0), cA, voffA); G8_STAGE(G8_SA(0, 1), cA + hstep, voffA);
            if (wr == 1) G8_BAR;
            G8_WAIT_V(2); G8_BAR;
            G8_STAGE(G8_SB(1, 0), cB + kstep, voffB); G8_STAGE(G8_SA(1, 0), cA + kstep, voffA); G8_STAGE(G8_SB(1, 1), cB + hstep + kstep, voffB);
            G8_WAIT_V(6); G8_BAR;
        }
        if constexpr (Epi::HAS_PRELOAD) E.preload(cur, lds, wid, lane, ui & 1);
        const bool chain = has_next && !drain && !Epi::TAIL_DMA;
        const char* nA = chain ? (const char*)g.A + (size_t)nxt.pm * tstep : cA; const char* nB = chain ? (const char*)g.Bt + (size_t)nxt.pn * tstep : cB;
        for (int t = 0; t < nt; t += 2) {
            const bool last = (t == nt - 2);
            const char* a1 = cA + (size_t)(t + 1) * kstep;
            const char* a2 = last ? nA : cA + (size_t)(t + 2) * kstep; const char* b2 = last ? nB : cB + (size_t)(t + 2) * kstep;
            const char* a3 = a2 + kstep; const char* b3 = b2 + kstep;
            const bool tl = Epi::TAIL_DMA && last && !chain;
            unsigned vA0 = voffA[0], vA1 = voffA[1], vB0 = voffB[0], vB1 = voffB[1];
            const char *s2a = b2, *s2b = b2 + hstep, *s2c = a2, *s3a = a2 + hstep, *s4a = b3, *s4b = b3 + hstep, *s4c = a3;
            if constexpr (Epi::TAIL_DMA) { if (tl) { const char* tb = E.tail_base(cur); const unsigned tv = E.tail_voff(wr, wc, lane_id());
#define G8_TC(c) ((size_t)(((((c) >> 2) * 128 + ((c) & 3) * 16) * E.tail_ld()) * 2))
                vA0 = vB0 = tv; vA1 = vB1 = tv + 256u;
                s2a = tb + G8_TC(0); s2b = tb + G8_TC(1); s2c = tb + G8_TC(2); s3a = tb + G8_TC(3); s4a = tb + G8_TC(4); s4b = tb + G8_TC(5); s4c = tb + G8_TC(6); } }
#undef G8_TC
            const unsigned vAs[2] = {vA0, vA1}, vBs[2] = {vB0, vB1};
            if constexpr (Epi::HAS_MID) { if (t == nt / 2 && !(flags & 2)) E.mid(acc, cur, wr, wc, fr, fq); }
            G8_LDB(B0, 0, 0); G8_LDB(B1, 0, 1); G8_SCHED; G8_LDA(At, 0, 0); G8_STAGE(G8_SA(1, 1), a1 + hstep, voffA);
            G8_WAIT_V(8); G8_WAIT_L(0); G8_BAR; G8_MMA(0, 0, At, B0); G8_MMA(0, 1, At, B1); G8_BAR; G8_SCHED;
            G8_LDA(At, 0, 1); G8_STAGE(G8_SB(0, 0), s2a, vBs); G8_STAGE(G8_SB(0, 1), s2b, vBs); G8_STAGE(G8_SA(0, 0), s2c, vAs);
            G8_WAIT_V(8); G8_WAIT_L(0); G8_BAR; G8_MMA(1, 0, At, B0); G8_MMA(1, 1, At, B1); G8_BAR; G8_SCHED;
            G8_LDB(B0, 1, 0); G8_LDB(B1, 1, 1); G8_SCHED; G8_LDA(At, 1, 0); G8_STAGE(G8_SA(0, 1), s3a, vAs);
            G8_WAIT_V(8); G8_WAIT_L(0); G8_BAR; G8_MMA(0, 0, At, B0); G8_MMA(0, 1, At, B1); G8_BAR; G8_SCHED;
            G8_LDA(At, 1, 1); G8_STAGE(G8_SB(1, 0), s4a, vBs); G8_STAGE(G8_SB(1, 1), s4b, vBs); G8_STAGE(G8_SA(1, 0), s4c, vAs);
            G8_WAIT_V(8); G8_WAIT_L(0); G8_BAR; G8_MMA(1, 0, At, B0); G8_MMA(1, 1, At, B1); G8_BAR; G8_SCHED;
        }
        if (drain) {
            G8_WAIT_V(0); if (wr == 0) G8_BAR; G8_BAR;
            if (has_next) {
                const char* pb = (const char*)g.Bt + (size_t)nxt.pn * tstep + (size_t)((unsigned)(tid >> 1) * (unsigned)(K * 2) + (unsigned)(tid & 1) * 128u);
                __builtin_amdgcn_global_load_lds((const unsigned*)pb, (LAS unsigned*)(lds + PF_DUMP_OFF + wid * 256), 4, 0, 0);
            }
            if constexpr (Epi::HAS_DRAIN) { if (!(flags & 1)) E.fused(acc, cur, wr, wc, fr, fq, lds, wid); }
            pro = true;
        } else {
            if (wr == 0) G8_BAR;
            if (!(flags & 1)) E(acc, cur, wr, wc, fr, fq); else { asm volatile("" :: "v"(acc[0][0][0][0]), "v"(acc[1][1][3][1]), "v"(acc[0][1][2][0]), "v"(acc[1][0][1][1])); if (Epi::USES_BAR) { G8_BAR; } }
            pro = Epi::TAIL_DMA;
        }
        if (!has_next) { if (!drain) { G8_WAIT_V(0); G8_BAR; } break; }
        cur = nxt; cA = (const char*)g.A + (size_t)cur.pm * tstep; cB = (const char*)g.Bt + (size_t)cur.pn * tstep; ++ui;
        if (!drain && !Epi::TAIL_DMA) { if (wr == 1) G8_BAR; }
    }
#undef G8_SA
#undef G8_SB
#undef G8_STAGE
#undef G8_LDA
#undef G8_LDB
#undef G8_MMA
#undef G8_WAIT_V
#undef G8_WAIT_L
#undef G8_SCHED
}
}
#define G8_BAR __builtin_amdgcn_s_barrier()

__device__ __forceinline__ int opaque_v(int x) { asm volatile("" : "+v"(x)); return x; }
__device__ __forceinline__ unsigned opaque_u(unsigned x) { asm volatile("" : "+v"(x)); return x; }
__device__ __forceinline__ int opaque_s(int x) { asm volatile("" : "+s"(x)); return x; }
__device__ __forceinline__ unsigned long long opaque_s64(unsigned long long x) { asm volatile("" : "+s"(x)); return x; }
constexpr bool WT_STORES = false;
__device__ __forceinline__ void st16(void* p, u32x4 v) {
    if (WT_STORES) asm volatile("global_store_dwordx4 %0, %1, off sc1\n\ts_nop 1" :: "v"(p), "v"(v) : "memory");
    else *(u32x4*)p = v;
}
__device__ __forceinline__ float fexp2(float x) { return __builtin_amdgcn_exp2f(x); }
__device__ __forceinline__ float frcp(float x) { return __builtin_amdgcn_rcpf(x); }
__device__ __forceinline__ float sigmoidf_(float x) { return frcp(1.f + fexp2(-LOG2E * x)); }
__device__ __forceinline__ float siluf_(float x) { return x * sigmoidf_(x); }
__device__ __forceinline__ unsigned pk2h(float lo, float hi) { f16x2 h; h.x = (f16)lo; h.y = (f16)hi; return __builtin_bit_cast(unsigned, h); }
__device__ __forceinline__ u32x4 pk8h(const f32x4 a, const f32x4 b) { u32x4 w; w.x = pk2h(a[0], a[1]); w.y = pk2h(a[2], a[3]); w.z = pk2h(b[0], b[1]); w.w = pk2h(b[2], b[3]); return w; }
__device__ __forceinline__ u32x2 pk8q(const f32x4 a, const f32x4 b) { int lo = 0, hi = 0;
    lo = __builtin_amdgcn_cvt_pk_fp8_f32(a[0], a[1], lo, false); lo = __builtin_amdgcn_cvt_pk_fp8_f32(a[2], a[3], lo, true);
    hi = __builtin_amdgcn_cvt_pk_fp8_f32(b[0], b[1], hi, false); hi = __builtin_amdgcn_cvt_pk_fp8_f32(b[2], b[3], hi, true);
    return (u32x2){(unsigned)lo, (unsigned)hi}; }
__device__ __forceinline__ void unpk8q(unsigned lo, unsigned hi, float (&v)[8]) {
    const f32x2 a = __builtin_amdgcn_cvt_pk_f32_fp8((int)lo, false), b = __builtin_amdgcn_cvt_pk_f32_fp8((int)lo, true), c = __builtin_amdgcn_cvt_pk_f32_fp8((int)hi, false), d = __builtin_amdgcn_cvt_pk_f32_fp8((int)hi, true);
    v[0] = a[0]; v[1] = a[1]; v[2] = b[0]; v[3] = b[1]; v[4] = c[0]; v[5] = c[1]; v[6] = d[0]; v[7] = d[1]; }
__device__ __forceinline__ void unpk8h(const u32x4 w, float (&v)[8]) {
    const f16x8 h = __builtin_bit_cast(f16x8, w);
#pragma unroll
    for (int e = 0; e < 8; ++e) v[e] = (float)h[e];
}

struct MixCtx {
    f16* U; const f16* WG;
    const float *conv4_w, *conv4_b, *b_a, *b_x, *nsp;
    const float *st_h, *st_c4;
    unsigned long long *gran, *hgran; unsigned* err; float* out; int layer, flags;
};

template <bool SAMPLE>
__device__ __forceinline__ void rnn_mixer(const MixCtx& C, LAS unsigned char* lds, int pm, int j, const int wave) {
    const int lane = opaque_v(lane_id()), tid = wave * 64 + lane;
    const int rb = tid >> 4, o = tid & 15, r0 = rb * 8, cb = 128 * j + 8 * o;
    const int grow0 = pm * 256 + r0;
    const int chunk = pm & 7, sq = pm >> 3;
    const unsigned epoch = (unsigned)C.layer + 1u;
    const unsigned lb = opaque_u((unsigned)(r0 * XC_STRIDE + 16 * o));
    if (C.flags & 16) return;
    {
        float up[11][8];
#pragma unroll
        for (int i = 0; i < 8; ++i) unpk8h(*(const LAS u32x4*)(lds + XC_OFF + lb + i * XC_STRIDE), up[3 + i]);
        if (SAMPLE) {
            const int b = (grow0 - MP) >> 3;
#pragma unroll
            for (int i = 0; i < 3; ++i) { const float* sp = C.st_c4 + ((size_t)b * 3 + i) * D + cb; const f32x4 a = *(const f32x4*)sp, c = *(const f32x4*)(sp + 4);
#pragma unroll
                for (int e = 0; e < 4; ++e) { up[i][e] = a[e]; up[i][4 + e] = c[e]; } }
        } else if (rb > 0) {
#pragma unroll
            for (int i = 0; i < 3; ++i) unpk8h(*(const LAS u32x4*)(lds + XC_OFF + lb + (i - 3) * XC_STRIDE), up[i]);
        } else if (chunk == 0) {
#pragma unroll
            for (int i = 0; i < 3; ++i)
#pragma unroll
                for (int e = 0; e < 8; ++e) up[i][e] = 0.f;
        } else {
            const unsigned long long* hp = C.hgran + ((size_t)((pm - 1) * 8 + j) * 3) * HB + 8 * o;
            unsigned spins = 0;
            for (;;) {
                bool ok = true;
#pragma unroll
                for (int i = 0; i < 3; ++i)
#pragma unroll
                    for (int e = 0; e < 8; ++e) { const unsigned long long x = __hip_atomic_load(hp + i * HB + e, RLX_AGENT); up[i][e] = __uint_as_float((unsigned)x); ok = ok && ((unsigned)(x >> 32) == epoch); }
                if (ok) break;
                __builtin_amdgcn_s_sleep(2);
                if (++spins > (1u << 22)) { __hip_atomic_store(C.err, 1u, RLX_AGENT); break; }
            }
        }
        float w4[4][8], b4[8];
#pragma unroll
        for (int k = 0; k < 4; ++k) { const f32x4 a = *(const f32x4*)(C.conv4_w + k * D + cb), c = *(const f32x4*)(C.conv4_w + k * D + cb + 4);
#pragma unroll
            for (int e = 0; e < 4; ++e) { w4[k][e] = a[e]; w4[k][4 + e] = c[e]; } }
        { const f32x4 a = *(const f32x4*)(C.conv4_b + cb), c = *(const f32x4*)(C.conv4_b + cb + 4);
#pragma unroll
            for (int e = 0; e < 4; ++e) { b4[e] = a[e]; b4[4 + e] = c[e]; } }
        LDS_WAIT(); __syncthreads();
#pragma unroll
        for (int rr = 0; rr < 8; ++rr) {
            f16x8 h;
#pragma unroll
            for (int e = 0; e < 8; ++e) h[e] = (f16)(b4[e] + w4[0][e] * up[rr][e] + w4[1][e] * up[rr + 1][e] + w4[2][e] * up[rr + 2][e] + w4[3][e] * up[rr + 3][e]);
            *(LAS f16x8*)(lds + XC_OFF + lb + rr * XC_STRIDE) = h;
        }
    }
    LDS_WAIT(); __syncthreads();
    if (C.flags & 32) return;
    const int c = lane & 15, g = lane >> 4, chl = 16 * wave + c, ch = 128 * j + chl;
    f16x8 Ba[4], Bx[4];
    { const f16* wa = C.WG + ((size_t)(j * 2 + 0) * HB + chl) * HB + 8 * g; const f16* wx = C.WG + ((size_t)(j * 2 + 1) * HB + chl) * HB + 8 * g;
#pragma unroll
        for (int kk = 0; kk < 4; ++kk) { Ba[kk] = *(const f16x8*)(wa + 32 * kk); Bx[kk] = *(const f16x8*)(wx + 32 * kk); } }
    const float ba = C.b_a[ch], bx = C.b_x[ch], nsp = C.nsp[ch], nsl = nsp * LN2;
    float k30 = 30.f, k6 = 1.f / 6.f, k24 = 1.f / 24.f, k120 = 1.f / 120.f, knl = -LOG2E;
    asm volatile("" : "+v"(k30), "+v"(k6), "+v"(k24), "+v"(k120), "+v"(knl));
    const float bla = knl * ba, blx = knl * bx;
    const bool fast = __all(nsl > -0.3f);
    f16x4 AT[16], HT[16];
    float Ac = 1.f, Hc = 0.f;
    const LAS unsigned char* xcrow = lds + XC_OFF + c * XC_STRIDE + 16 * g;
    const LAS unsigned char* xcel = lds + XC_OFF + (4 * g) * XC_STRIDE + 2 * chl;
    LAS unsigned char* sgel = lds + SG_OFF + (4 * g) * XC_STRIDE + 2 * chl;
    f32x4 ga_n = {0.f, 0.f, 0.f, 0.f}, gx_n = {0.f, 0.f, 0.f, 0.f}; f16 xc_n[4];
#define MIX_GATES(RF) { ga_n = (f32x4){0.f, 0.f, 0.f, 0.f}; gx_n = ga_n; \
        _Pragma("unroll") for (int kk = 0; kk < 4; ++kk) { const f16x8 a = *(const LAS f16x8*)(xcrow + (16 * (RF)) * XC_STRIDE + 64 * kk); \
            ga_n = __builtin_amdgcn_mfma_f32_16x16x32_f16(a, Ba[kk], ga_n, 0, 0, 0); gx_n = __builtin_amdgcn_mfma_f32_16x16x32_f16(a, Bx[kk], gx_n, 0, 0, 0); } \
        _Pragma("unroll") for (int e = 0; e < 4; ++e) xc_n[e] = *(const LAS f16*)(xcel + (16 * (RF) + e) * XC_STRIDE); }
    MIX_GATES(0)
#pragma unroll
    for (int rf = 0; rf < 16; ++rf) {
        const f32x4 ga = ga_n, gx = gx_n; const f16 xcv[4] = {xc_n[0], xc_n[1], xc_n[2], xc_n[3]};
        if (rf + 1 < 16) MIX_GATES(rf + 1)
        float a4[4], b4_[4];
        if (fast) {
#pragma unroll
            for (int h = 0; h < 2; ++h) {
                const f32x2 gav = {ga[2 * h], ga[2 * h + 1]}, gxv = {gx[2 * h], gx[2 * h + 1]};
                const f32x2 ta = gav * knl + bla, tx = gxv * knl + blx;
                f32x2 ea, ex; ea.x = fexp2(ta.x); ea.y = fexp2(ta.y); ex.x = fexp2(tx.x); ex.y = fexp2(tx.y);
                ea = ea + 1.f; ex = ex + 1.f;
                f32x2 r, ig; r.x = frcp(ea.x); r.y = frcp(ea.y); ig.x = frcp(ex.x); ig.y = frcp(ex.y);
                const f32x2 y = r * nsl;
                f32x2 d = y * k120 + k24; d = d * y + k6; d = d * y + 0.5f; d = d * y + 1.f; d = d * y;
                const f32x2 av = d + 1.f, m2 = -d * (d + 2.f);
                f32x2 mult; mult.x = __builtin_amdgcn_sqrtf(m2.x); mult.y = __builtin_amdgcn_sqrtf(m2.y);
                if (!SAMPLE) { if (h == 0 && chunk == 0 && rf == 0 && g == 0) mult.x = 1.f; }
                f32x2 xc; xc.x = (float)xcv[2 * h]; xc.y = (float)xcv[2 * h + 1];
                const f32x2 bv = mult * ig * xc;
                a4[2 * h] = av.x; a4[2 * h + 1] = av.y; b4_[2 * h] = bv.x; b4_[2 * h + 1] = bv.y;
            }
        } else {
#pragma unroll
            for (int e = 0; e < 4; ++e) {
                const float r = sigmoidf_(__builtin_amdgcn_fmed3f(ga[e] + ba, -k30, k30)), ig = sigmoidf_(__builtin_amdgcn_fmed3f(gx[e] + bx, -k30, k30));
                const float l2a = r * nsp, x2 = 2.f * LN2 * l2a;
                const float a = fexp2(l2a);
                const float em = x2 * (1.f + x2 * (0.5f + x2 * (k6 + x2 * (k24 + x2 * (k120 + x2 * (k120 * (1.f / 6.f)))))));
                const float m2 = (x2 > -0.3f) ? -em : (1.f - a * a);
                float mult = __builtin_amdgcn_sqrtf(fmaxf(m2, 0.f));
                if (!SAMPLE) { if (chunk == 0 && rf == 0 && g == 0 && e == 0) mult = 1.f; }
                const float xc = (float)xcv[e];
                a4[e] = a; b4_[e] = mult * ig * xc;
            }
        }
        f32x4 Ap, Hp; float Ar = 1.f, Hr = 0.f;
#pragma unroll
        for (int e = 0; e < 4; ++e) { Hr = a4[e] * Hr + b4_[e]; Ar = a4[e] * Ar; Ap[e] = Ar; Hp[e] = Hr; }
        if (SAMPLE) {
            const int b = (pm - 64) * 32 + 2 * rf + (g >> 1);
            float hin = C.st_h[(size_t)b * D + ch];
            const float Apv = __shfl_up(Ar, 16), Hpv = __shfl_up(Hr, 16);
            if (g & 1) hin = Apv * hin + Hpv;
#pragma unroll
            for (int e = 0; e < 4; ++e) { const float h = Ap[e] * hin + Hp[e];
                LAS f16* sg = (LAS f16*)(sgel + (16 * rf + e) * XC_STRIDE); *sg = (f16)(h * (float)*sg);
                if ((g & 1) && e == 3) C.out[O_RS + ((size_t)C.layer * DECB + b) * D + ch] = h; }
        } else {
            float Ai = Ar, Hi = Hr;
            { const float Aq = __shfl_up(Ai, 16), Hq = __shfl_up(Hi, 16); if (g >= 1) { Hi = Ai * Hq + Hi; Ai = Ai * Aq; } }
            { const float Aq = __shfl_up(Ai, 32), Hq = __shfl_up(Hi, 32); if (g >= 2) { Hi = Ai * Hq + Hi; Ai = Ai * Aq; } }
            float Ae = __shfl_up(Ai, 16), He = __shfl_up(Hi, 16); if (g == 0) { Ae = 1.f; He = 0.f; }
            const float Ab = __shfl(Ai, 48 + c), Hb = __shfl(Hi, 48 + c);
            const float Ax = Ae * Ac, Hx = Ae * Hc + He;
#pragma unroll
            for (int e = 0; e < 4; ++e) { AT[rf][e] = (f16)(Ap[e] * Ax); HT[rf][e] = (f16)(Ap[e] * Hx + Hp[e]); }
            asm volatile("" : "+v"(AT[rf]), "+v"(HT[rf]));
            Hc = Ab * Hc + Hb; Ac = Ab * Ac;
        }
    }
    if (C.flags & 128) { asm volatile("" :: "v"(Ac), "v"(Hc), "v"(AT[15]), "v"(HT[7])); return; }
    if (!SAMPLE) {
        unsigned long long* gbase = C.gran + ((size_t)((sq * 8 + chunk) * 8 + j) * HB) * 2;
        if (g == 0 && chunk < 7) {
            __hip_atomic_store(gbase + chl * 2 + 0, ((unsigned long long)epoch << 32) | __float_as_uint(Ac), RLX_AGENT);
            __hip_atomic_store(gbase + chl * 2 + 1, ((unsigned long long)epoch << 32) | __float_as_uint(Hc), RLX_AGENT);
        }
        if (!(C.flags & 256))
#pragma unroll
        for (int rf = 0; rf < 16; ++rf)
#pragma unroll
            for (int e = 0; e < 4; ++e) { const float sgv = (float)*(const LAS f16*)(sgel + (16 * rf + e) * XC_STRIDE); AT[rf][e] = (f16)((float)AT[rf][e] * sgv); HT[rf][e] = (f16)((float)HT[rf][e] * sgv); }
        float Ag = 1.f, Hg = 0.f;
        {
            const unsigned long long* gp0 = C.gran + ((size_t)((sq * 8 + 2 * g) * 8 + j) * HB + chl) * 2;
            const bool n0 = 2 * g < chunk && !(C.flags & 64), n1 = 2 * g + 1 < chunk && !(C.flags & 64);
            unsigned long long xa0 = 0, xh0 = 0, xa1 = 0, xh1 = 0; unsigned spins = 0;
            for (;;) {
                bool ok = true;
                if (n0) { xa0 = __hip_atomic_load(gp0, RLX_AGENT); xh0 = __hip_atomic_load(gp0 + 1, RLX_AGENT); }
                if (n1) { xa1 = __hip_atomic_load(gp0 + 8 * HB * 2, RLX_AGENT); xh1 = __hip_atomic_load(gp0 + 8 * HB * 2 + 1, RLX_AGENT); }
                if (n0) ok = ok && ((unsigned)(xa0 >> 32) == epoch) && ((unsigned)(xh0 >> 32) == epoch);
                if (n1) ok = ok && ((unsigned)(xa1 >> 32) == epoch) && ((unsigned)(xh1 >> 32) == epoch);
                if (ok) break;
                __builtin_amdgcn_s_sleep(2);
                if (++spins > (1u << 22)) { __hip_atomic_store(C.err, 1u, RLX_AGENT); break; }
            }
            if (n0) { Ag = __uint_as_float((unsigned)xa0); Hg = __uint_as_float((unsigned)xh0); }
            if (n1) { const float a1 = __uint_as_float((unsigned)xa1), h1 = __uint_as_float((unsigned)xh1); Hg = a1 * Hg + h1; Ag = a1 * Ag; }
        }
        { const float Aq = __shfl_up(Ag, 16), Hq = __shfl_up(Hg, 16); if (g >= 1) { Hg = Ag * Hq + Hg; Ag = Ag * Aq; } }
        { const float Aq = __shfl_up(Ag, 32), Hq = __shfl_up(Hg, 32); if (g >= 2) { Hg = Ag * Hq + Hg; Ag = Ag * Aq; } }
        float hin = __shfl(Hg, 48 + c);
        if (!(C.flags & 256))
#pragma unroll
        for (int rf = 0; rf < 16; ++rf)
#pragma unroll
            for (int e = 0; e < 4; ++e) *(LAS f16*)(sgel + (16 * rf + e) * XC_STRIDE) = (f16)((float)AT[rf][e] * hin + (float)HT[rf][e]);
        if (chunk == 7 && g == 0) C.out[O_RP + ((size_t)C.layer * BATCH + sq) * D + ch] = Ac * hin + Hc;
    }
    LDS_WAIT(); __syncthreads();
    if (!(C.flags & 512)) { const unsigned uo2 = opaque_u(((unsigned)grow0 * 2048u + cb) * 2u); const unsigned lb2 = opaque_u((unsigned)(r0 * XC_STRIDE + 16 * o));
#pragma unroll
    for (int rr = 0; rr < 8; ++rr) st16((char*)C.U + (size_t)(uo2 + (unsigned)(rr * 2048 * 2)), *(const LAS u32x4*)(lds + SG_OFF + lb2 + rr * XC_STRIDE)); }
    LDS_WAIT(); __syncthreads();
}

struct ConvCtx { f16* U; const float *conv3_w, *st_c3; unsigned long long* cgran; unsigned* err; float* out; int layer; };

__device__ __forceinline__ void row_mu_rstd(const float* stats, unsigned row, float& mu, float& rstd) {
    const f32x4 s0 = *(const f32x4*)((const char*)stats + (size_t)(row * 32u)), s1 = *(const f32x4*)((const char*)stats + (size_t)(row * 32u + 16u));
    const float sum = (s0[0] + s0[2]) + (s1[0] + s1[2]), sq = (s0[1] + s0[3]) + (s1[1] + s1[3]);
    mu = sum * (1.f / D); const float var = sq * (1.f / D) - mu * mu; rstd = __builtin_amdgcn_rsqf(var + LN_EPS);
}

__device__ __forceinline__ void row_mu_rstd_s(const float* ss, unsigned srow, float& mu, float& rstd) {
    float sum = 0.f, sq = 0.f;
#pragma unroll
    for (int i = 0; i < 8; ++i) { const f32x4 v = *(const f32x4*)((const char*)ss + (size_t)(srow * 128u + (unsigned)i * 16u)); sum += v[0] + v[2]; sq += v[1] + v[3]; }
    mu = sum * (1.f / D); const float var = sq * (1.f / D) - mu * mu; rstd = __builtin_amdgcn_rsqf(var + LN_EPS);
}

__device__ __forceinline__ void rows_mu_rstd(const float* stats, unsigned row0, unsigned lrow, int fq, float (&mu)[2][4], float (&rstd)[2][4]) {
    f32x2 st[2][4];
#pragma unroll
    for (int ai = 0; ai < 2; ++ai)
#pragma unroll
        for (int m = 0; m < 4; ++m) st[ai][m] = *(const f32x2*)((const char*)stats + (size_t)((row0 + lrow + (unsigned)(ai * 128 + m * 16)) * 32u + (unsigned)fq * 8u));
    float invd = 1.f / D; asm volatile("" : "+v"(invd));
#pragma unroll
    for (int ai = 0; ai < 2; ++ai)
#pragma unroll
        for (int m = 0; m < 4; ++m) { float sm = st[ai][m].x, sq = st[ai][m].y;
            sm += __shfl_xor(sm, 16); sq += __shfl_xor(sq, 16); sm += __shfl_xor(sm, 32); sq += __shfl_xor(sq, 32);
            const float u = sm * invd; mu[ai][m] = u; rstd[ai][m] = __builtin_amdgcn_rsqf(sq * invd - u * u + LN_EPS); }
}

struct Epi1 {
    static constexpr bool PERM = true, HAS_MID = false, USES_BAR = false, HAS_DRAIN = true, HAS_PRELOAD = true, TAIL_DMA = false;
    unsigned char* wsb; const float *c1, *c2, *stats; float* out; int layer; MixCtx mix; ConvCtx cv;
    LAS unsigned char* ldsb; mutable int tab_pm; mutable int ctab; const float* sstats;
    __device__ __forceinline__ void row_table(const g8::Unit& u, int wid) const {
        if (u.pm == tab_pm) return;
        tab_pm = u.pm;
        const unsigned t = opaque_u((unsigned)(wid * 64 + lane_id()));
        if (t < 256u) { float mu = 0.f, rstd = 1.f; if (stats) { if (u.pm >= 64) row_mu_rstd_s(sstats, (unsigned)((u.pm - 64) * 256) + t, mu, rstd); else row_mu_rstd(stats, (unsigned)(u.pm * 256) + t, mu, rstd); } *(LAS f32x2*)(ldsb + ROWTAB_OFF + 8u * t) = (f32x2){mu, rstd}; }
        LDS_WAIT(); G8_BAR; asm volatile("" ::: "memory");
    }
    __device__ __forceinline__ bool drains(const g8::Unit& u) const { return u.pn < 8; }
    __device__ __forceinline__ void preload(const g8::Unit& u, LAS unsigned char* lds, int wid, int lane, int par) const {
        const float* src = (wid < 4 ? c1 : c2) + u.pn * 256 + (wid & 3) * 64 + lane;
        ctab = C1C2_OFF + par * 2048;
        __builtin_amdgcn_global_load_lds((const unsigned*)src, (LAS unsigned*)(lds + ctab + wid * 256), 4, 0, 0);
    }
    __device__ __forceinline__ void fused(const f32x4 (&acc)[2][2][4][2], const g8::Unit& u, int wr, int wc, int fr, int fq, LAS unsigned char* lds, int wid) const {
        const int j = u.pn & 7;
        const unsigned lcol = opaque_u((unsigned)(wc * 32 + 8 * fq));
        const unsigned lrow = opaque_u((unsigned)(wr * 64 + fr));
        f32x4 c1v[2][2], c2v[2][2];
#pragma unroll
        for (int bj = 0; bj < 2; ++bj)
#pragma unroll
            for (int n = 0; n < 2; ++n) { c1v[bj][n] = *(const LAS f32x4*)(ldsb + ctab + (lcol + bj * 128 + 4 * n) * 4u); c2v[bj][n] = *(const LAS f32x4*)(ldsb + ctab + 1024 + (lcol + bj * 128 + 4 * n) * 4u); }
        const int row0u = u.pm * 256; const bool smp = row0u >= MP;
        const bool isr = true, sil = true;
        const unsigned epoch = (unsigned)layer + 1u;
        row_table(u, wid);
#pragma unroll
        for (int it = 0; it < 8; ++it) {
                const int ai = ((it + 7) & 7) >> 2, m = (it + 7) & 3;
                const unsigned rl = lrow + (unsigned)(ai * 128 + m * 16);
                const unsigned row = (unsigned)row0u + rl;
                const f32x2 mr = *(const LAS f32x2*)(ldsb + ROWTAB_OFF + 8u * rl); const float mu = mr.x, rstd = mr.y;
                f32x4 z[2][2];
#pragma unroll
                for (int bj = 0; bj < 2; ++bj)
#pragma unroll
                    for (int n = 0; n < 2; ++n) z[bj][n] = (acc[ai][bj][m][n] - mu * c1v[bj][n]) * rstd + c2v[bj][n];
                const unsigned lo = rl * XC_STRIDE + lcol * 2u;
                *(LAS u32x4*)(lds + XC_OFF + lo) = pk8h(z[0][0], z[0][1]);
                f32x4 g0, g1;
#pragma unroll
                for (int e = 0; e < 4; ++e) { const float a0 = z[1][0][e], a1 = z[1][1][e]; g0[e] = sil ? siluf_(a0) : a0; g1[e] = sil ? siluf_(a1) : a1; }
                *(LAS u32x4*)(lds + SG_OFF + lo) = pk8h(g0, g1);
                const int t = smp ? ((row - MP) & 7) : (row & (SEQ - 1)); const int T = smp ? DECS : SEQ; const int sb = smp ? ((row - MP) >> 3) : (row >> 11);
                if (isr && t >= T - 3) { float* dst = out + (smp ? O_C4S : O_C4P) + ((size_t)(layer * (smp ? DECB : BATCH) + sb) * 3 + (t - (T - 3))) * D + 128 * j + lcol;
                    *(f32x4*)dst = z[0][0]; *(f32x4*)(dst + 4) = z[0][1]; }
                if (ai == 1 && m == 3) {
                    if (isr && !smp && (u.pm & 7) < 7 && rl >= 253u) { unsigned long long* hp = mix.hgran + ((size_t)(u.pm * 8 + j) * 3 + (rl - 253u)) * HB + lcol;
#pragma unroll
                        for (int e = 0; e < 4; ++e) { __hip_atomic_store(hp + e, ((unsigned long long)epoch << 32) | __float_as_uint(z[0][0][e]), RLX_AGENT);
                                                      __hip_atomic_store(hp + 4 + e, ((unsigned long long)epoch << 32) | __float_as_uint(z[0][1][e]), RLX_AGENT); } }
                }
            }
        LDS_WAIT(); G8_BAR; asm volatile("" ::: "memory");
        if (smp) rnn_mixer<true>(mix, lds, u.pm, j, wid); else rnn_mixer<false>(mix, lds, u.pm, j, wid);
    }
    template <bool SMP>
    __device__ __forceinline__ void conv_epi(const f32x4 (&acc)[2][2][4][2], const g8::Unit& u, int wr, int wc, int fr_, int fq) const {
        const int k = u.pn - 8, chunk = u.pm & 7;
        const int fr = opaque_v(fr_);
        const unsigned lcol = opaque_u((unsigned)(wc * 32 + 8 * fq));
        const unsigned lrow = opaque_u((unsigned)(wr * 64 + fr));
        const unsigned chl = opaque_u((unsigned)(wc * 16 + 4 * fq));
        const unsigned chg = (unsigned)(64 * k) + chl;
        f32x4 c1v[2][2], c2v[2][2];
#pragma unroll
        for (int bj = 0; bj < 2; ++bj)
#pragma unroll
            for (int n = 0; n < 2; ++n) { c1v[bj][n] = *(const LAS f32x4*)(ldsb + ctab + (lcol + bj * 128 + 4 * n) * 4u); c2v[bj][n] = *(const LAS f32x4*)(ldsb + ctab + 1024 + (lcol + bj * 128 + 4 * n) * 4u); }
        f32x4 w3[3];
#pragma unroll
        for (int kk = 0; kk < 3; ++kk) w3[kk] = *(const f32x4*)((const char*)cv.conv3_w + (size_t)(((unsigned)(kk * D) + chg) * 4u));
        const int row0u = u.pm * 256;
        const unsigned epoch = (unsigned)layer + 1u;
        row_table(u, wr * 4 + wc);
#define CE_ROR(v, n) __int_as_float(__builtin_amdgcn_mov_dpp(__float_as_int(v), 0x120 + (n), 0xf, 0xf, true))
        f32x4 H1[2], H2[2];
        if (!SMP) {
            LAS unsigned char* halo = ldsb + CONV_HALO_OFF;
#pragma unroll
            for (int ai = 0; ai < 2; ++ai) {
                const unsigned rl = lrow + (unsigned)(ai * 128 + 48);
                const f32x2 mr = *(const LAS f32x2*)(ldsb + ROWTAB_OFF + 8u * rl);
                const f32x4 cc = (acc[ai][0][3][1] - mr.x * c1v[0][1]) * mr.y + c2v[0][1], chh = (acc[ai][1][3][1] - mr.x * c1v[1][1]) * mr.y + c2v[1][1];
                const f32x4 pl = cc * chh;
                if (fr >= 14) {
                    *(LAS f32x4*)(halo + (unsigned)(((2 * ai + wr) * 2 + (fr - 14)) * 256) + chl * 4u) = pl;
                    if (ai == 1 && wr == 1) {
                        if (chunk < 7) { unsigned long long* cg = cv.cgran + ((size_t)(u.pm * 16 + k) * 2 + (fr - 14)) * 64 + chl;
#pragma unroll
                            for (int e = 0; e < 4; ++e) __hip_atomic_store(cg + e, ((unsigned long long)epoch << 32) | __float_as_uint(pl[e]), RLX_AGENT); }
                        else *(f32x4*)(out + O_C3P + ((size_t)(layer * BATCH + (u.pm >> 3)) * 2 + (fr - 14)) * D + chg) = pl;
                    }
                }
            }
            LDS_WAIT(); G8_BAR; asm volatile("" ::: "memory");
        }
        char* ub = (char*)cv.U + ((size_t)row0u * 2048 + 1024) * 2;
#pragma unroll
        for (int aa = 0; aa < 2; ++aa) {
            const int ai = 1 - aa;
            if (!SMP) {
                LAS unsigned char* halo = ldsb + CONV_HALO_OFF;
                if (ai == 1 || wr == 1) { const unsigned so = (unsigned)(((2 * ai + wr - 1) * 2) * 256) + chl * 4u;
                    H2[ai] = *(const LAS f32x4*)(halo + so); H1[ai] = *(const LAS f32x4*)(halo + so + 256u); }
                else { H1[0] = (f32x4){0.f, 0.f, 0.f, 0.f}; H2[0] = H1[0];
                    if (chunk > 0 && fr < 2) {
                        const unsigned long long* cg = cv.cgran + ((size_t)((u.pm - 1) * 16 + k) * 2) * 64 + chl; unsigned spins = 0;
                        for (;;) { bool ok = true;
#pragma unroll
                            for (int e = 0; e < 4; ++e) { const unsigned long long x2 = __hip_atomic_load(cg + e, RLX_AGENT), x1 = __hip_atomic_load(cg + 64 + e, RLX_AGENT);
                                H2[0][e] = __uint_as_float((unsigned)x2); H1[0][e] = __uint_as_float((unsigned)x1); ok = ok && ((unsigned)(x2 >> 32) == epoch) && ((unsigned)(x1 >> 32) == epoch); }
                            if (ok) break;
                            __builtin_amdgcn_s_sleep(2);
                            if (++spins > (1u << 22)) { __hip_atomic_store(cv.err, 1u, RLX_AGENT); break; } }
                    }
                }
            }
            f32x4 Pp = {0.f, 0.f, 0.f, 0.f};
#pragma unroll
            for (int m = 0; m < 4; ++m) {
                const unsigned rl = lrow + (unsigned)(ai * 128 + m * 16);
                const f32x2 mr = *(const LAS f32x2*)(ldsb + ROWTAB_OFF + 8u * rl); const float mu = mr.x, rstd = mr.y;
                const f32x4 cb = (acc[ai][0][m][0] - mu * c1v[0][0]) * rstd + c2v[0][0], cc = (acc[ai][0][m][1] - mu * c1v[0][1]) * rstd + c2v[0][1];
                const f32x4 gc = (acc[ai][1][m][0] - mu * c1v[1][0]) * rstd + c2v[1][0], chh = (acc[ai][1][m][1] - mu * c1v[1][1]) * rstd + c2v[1][1];
                const f32x4 pl = cc * chh;
                f32x4 q, pm1, pm2;
#pragma unroll
                for (int e = 0; e < 4; ++e) q[e] = cb[e] * siluf_(gc[e]);
                if (SMP) {
                    const int f7 = fr & 7; const unsigned b = ((unsigned)row0u + rl - (unsigned)MP) >> 3;
                    const f32x4 st0 = *(const f32x4*)((const char*)cv.st_c3 + (size_t)(((b * 2u) * D + chg) * 4u)), st1 = *(const f32x4*)((const char*)cv.st_c3 + (size_t)(((b * 2u + 1u) * D + chg) * 4u));
#pragma unroll
                    for (int e = 0; e < 4; ++e) { const float r1 = CE_ROR(pl[e], 1), r2 = CE_ROR(pl[e], 2); pm1[e] = f7 >= 1 ? r1 : st1[e]; pm2[e] = f7 >= 2 ? r2 : (f7 == 1 ? st1[e] : st0[e]); }
                    if (f7 >= 6) *(f32x4*)(out + O_C3S + ((size_t)(layer * DECB + b) * 2 + (f7 - 6)) * D + chg) = pl;
                } else {
#pragma unroll
                    for (int e = 0; e < 4; ++e) { const float r1 = CE_ROR(pl[e], 1), r2 = CE_ROR(pl[e], 2);
                        const float v1 = m == 0 ? H1[ai][e] : CE_ROR(Pp[e], 1), v2 = m == 0 ? (fr == 1 ? H1[ai][e] : H2[ai][e]) : CE_ROR(Pp[e], 2);
                        pm1[e] = fr >= 1 ? r1 : v1; pm2[e] = fr >= 2 ? r2 : v2; }
                }
                f32x4 v;
#pragma unroll
                for (int e = 0; e < 4; ++e) v[e] = q[e] * (w3[0][e] * pm2[e] + w3[1][e] * pm1[e] + w3[2][e] * pl[e]);
                *(u32x2*)(ub + (size_t)((rl * 2048u + chg) * 2u)) = (u32x2){pk2h(v[0], v[1]), pk2h(v[2], v[3])};
                Pp = pl;
                asm volatile("" ::: "memory");
            }
        }
#undef CE_ROR
    }
    __device__ __forceinline__ void operator()(const f32x4 (&acc)[2][2][4][2], const g8::Unit& u, int wr, int wc, int fr, int fq) const {
        if (u.pn < 24) { if (u.pm * 256 >= MP) conv_epi<true>(acc, u, wr, wc, fr, fq); else conv_epi<false>(acc, u, wr, wc, fr, fq); return; }
        const int type = 3, j = u.pn & 7;
        const unsigned lcol = opaque_u((unsigned)(wc * 32 + 8 * fq));
        const unsigned lrow = opaque_u((unsigned)(wr * 64 + fr));
        f32x4 c1v[2][2], c2v[2][2];
#pragma unroll
        for (int bj = 0; bj < 2; ++bj)
#pragma unroll
            for (int n = 0; n < 2; ++n) { c1v[bj][n] = *(const LAS f32x4*)(ldsb + ctab + (lcol + bj * 128 + 4 * n) * 4u); c2v[bj][n] = *(const LAS f32x4*)(ldsb + ctab + 1024 + (lcol + bj * 128 + 4 * n) * 4u); }
        const size_t ub = ((size_t)u.pm * 256 * D + 128 * j) * 2;
        char* o0 = (char*)wsb + (type == 1 ? WS_Q : type == 2 ? WS_P : WS_GR) + ub;
        char* o1 = (char*)wsb + WS_GC + ub;
        const int row0u = u.pm * 256;
        row_table(u, wr * 4 + wc);
#pragma unroll
        for (int ai = 0; ai < 2; ++ai)
#pragma unroll
            for (int m = 0; m < 4; ++m) {
                const unsigned rl = lrow + (unsigned)(ai * 128 + m * 16);
                const unsigned row = (unsigned)row0u + rl;
                const f32x2 mr = *(const LAS f32x2*)(ldsb + ROWTAB_OFF + 8u * rl); const float mu = mr.x, rstd = mr.y;
                f32x4 z[2][2];
#pragma unroll
                for (int bj = 0; bj < 2; ++bj)
#pragma unroll
                    for (int n = 0; n < 2; ++n) z[bj][n] = (acc[ai][bj][m][n] - mu * c1v[bj][n]) * rstd + c2v[bj][n];
                const unsigned o = (rl * D + lcol) * 2u;
                const bool smp = row >= (unsigned)MP; const int t = smp ? ((row - MP) & 7) : (row & (SEQ - 1)); const int T = smp ? DECS : SEQ; const int sb = smp ? ((row - MP) >> 3) : (row >> 11);
                if (type == 1) {
                    f32x4 q0, q1;
#pragma unroll
                    for (int e = 0; e < 4; ++e) { q0[e] = z[0][0][e] * siluf_(z[1][0][e]); q1[e] = z[0][1][e] * siluf_(z[1][1][e]); }
                    st16(o0 + (size_t)o, pk8h(q0, q1));
                } else if (type == 2) {
                    const f32x4 p0 = z[0][0] * z[1][0], p1 = z[0][1] * z[1][1];
                    st16(o0 + (size_t)o, pk8h(p0, p1));
                    if (t >= T - 2) { float* dst = out + (smp ? O_C3S : O_C3P) + ((size_t)(layer * (smp ? DECB : BATCH) + sb) * 2 + (t - (T - 2))) * D + 128 * j + lcol;
                        *(f32x4*)dst = p0; *(f32x4*)(dst + 4) = p1; }
                } else {
                    const u32x2 qr = pk8q(z[0][0], z[0][1]), qc = pk8q(z[1][0], z[1][1]);
                    st16(o0 + (size_t)o, (u32x4){qr.x, qr.y, qc.x, qc.y});
                }
                asm volatile("" ::: "memory");
            }
    }
};

struct Epi3 {
    static constexpr bool PERM = true, HAS_MID = true, USES_BAR = false, HAS_DRAIN = false, HAS_PRELOAD = false, TAIL_DMA = true;
    const f16 *GR; f16* M16; const LAS unsigned char* lut;
    LAS unsigned char* ldsb;
    __device__ __forceinline__ const char* tail_base(const g8::Unit& u) const { return (const char*)GR + ((size_t)u.pm * 256 * D + u.pn * 256) * 2; }
    __device__ __forceinline__ unsigned tail_voff(int wr, int wc, int lane) const { return (unsigned)(((wr * 64 + (lane & 15)) * D + wc * 32 + 8 * (lane >> 4)) * 2); }
    __device__ __forceinline__ int tail_ld() const { return D; }
    __device__ __forceinline__ void mid(f32x4 (&acc)[2][2][4][2], const g8::Unit& u, int wr, int wc, int fr, int fq) const {
        const unsigned lo = opaque_u((unsigned)(((wr * 64 + fr) * D + wc * 32 + 8 * fq) * 2));
        const size_t ub = ((size_t)u.pm * 256 * D + u.pn * 256) * 2;
        const char* gb = (const char*)GR + ub;
        const LAS unsigned char* lt = lut;
#define E3_OFF(i) (lo + (unsigned)(((((i) >> 3) * 128 + (((i) >> 1) & 3) * 16) * D + ((i) & 1) * 128) * 2))
#define E3_SIG(w, k) (*(const LAS float*)(lt + (((w) >> (8 * (k))) & 0xffu) * 4u))
#define E3_INV(w, k) (*(const LAS float*)(lt + 1024 + (((w) >> (8 * (k))) & 0xffu) * 4u))
        u32x4 r0 = *(const u32x4*)(gb + (size_t)E3_OFF(0)), r1 = *(const u32x4*)(gb + (size_t)E3_OFF(1)), r2 = *(const u32x4*)(gb + (size_t)E3_OFF(2)), r3 = *(const u32x4*)(gb + (size_t)E3_OFF(3));
        u32x4 r4 = *(const u32x4*)(gb + (size_t)E3_OFF(4)), r5 = *(const u32x4*)(gb + (size_t)E3_OFF(5)), r6 = *(const u32x4*)(gb + (size_t)E3_OFF(6)), r7 = *(const u32x4*)(gb + (size_t)E3_OFF(7));
#define E3_MID_STEP(i, RS) { const int ai = (i) >> 3, m = ((i) >> 1) & 3, bj = (i) & 1; const u32x4 cr = RS; \
            if ((i) + 8 < 16) RS = *(const u32x4*)(gb + (size_t)E3_OFF((i) + 8)); \
            _Pragma("unroll") for (int e = 0; e < 4; ++e) { acc[ai][bj][m][0][e] *= E3_SIG(cr.x, e) * E3_INV(cr.z, e); acc[ai][bj][m][1][e] *= E3_SIG(cr.y, e) * E3_INV(cr.w, e); } \
            asm volatile("" ::: "memory"); }
#pragma unroll
        for (int i0 = 0; i0 < 16; i0 += 8) { E3_MID_STEP(i0, r0) E3_MID_STEP(i0 + 1, r1) E3_MID_STEP(i0 + 2, r2) E3_MID_STEP(i0 + 3, r3) E3_MID_STEP(i0 + 4, r4) E3_MID_STEP(i0 + 5, r5) E3_MID_STEP(i0 + 6, r6) E3_MID_STEP(i0 + 7, r7) }
#undef E3_MID_STEP
    }
    __device__ __forceinline__ void operator()(const f32x4 (&acc)[2][2][4][2], const g8::Unit& u, int wr, int wc, int fr, int fq) const {
        const unsigned lo = opaque_u((unsigned)(((wr * 64 + fr) * D + wc * 32 + 8 * fq) * 2));
        const size_t ub = ((size_t)u.pm * 256 * D + u.pn * 256) * 2;
        const char* gb = (const char*)GR + ub + 8; char* mb = (char*)M16 + ub;
        const LAS unsigned char* lt = lut;
        u32x2 c6 = *(const u32x2*)(gb + (size_t)E3_OFF(14)), c7 = *(const u32x2*)(gb + (size_t)E3_OFF(15));
        asm volatile("s_waitcnt vmcnt(0)" ::: "memory");
        const LAS unsigned char* lp = ldsb + (wr * 4 + wc) * 1024 + opaque_u((unsigned)lane_id()) * 16u + 8u;
#define E3_SLOT(c) ((c) == 0 ? 4 : (c) == 1 ? 5 : (c) == 2 ? 0 : (c) == 3 ? 1 : (c) == 4 ? 6 : (c) == 5 ? 7 : 2)
#define E3_FIN_STEP(i) { const int ai = (i) >> 3, m = ((i) >> 1) & 3, bj = (i) & 1; \
            const u32x2 cc = (i) < 14 ? *(const LAS u32x2*)(lp + E3_SLOT((i) >> 1) * 16384 + ((i) & 1) * 8192) : ((i) == 14 ? c6 : c7); \
            f32x4 v0, v1; \
            _Pragma("unroll") for (int e = 0; e < 4; ++e) { v0[e] = acc[ai][bj][m][0][e] * E3_SIG(cc.x, e); v1[e] = acc[ai][bj][m][1][e] * E3_SIG(cc.y, e); } \
            st16(mb + (size_t)E3_OFF(i), pk8h(v0, v1)); asm volatile("" ::: "memory"); }
#pragma unroll
        for (int i = 0; i < 16; ++i) E3_FIN_STEP(i)
#undef E3_SLOT
#undef E3_FIN_STEP
#undef E3_SIG
#undef E3_INV
#undef E3_OFF
    }
};

struct Epi4 {
    static constexpr bool PERM = true, HAS_MID = false, USES_BAR = true, HAS_DRAIN = false, HAS_PRELOAD = false, TAIL_DMA = true;
    const float* xp; f16* S16; const float* stats_prev; float* stats_out; const float *g_prev, *b_prev; LAS f32x2* tab; int layer; LAS unsigned char* ldsb;
    __device__ __forceinline__ const char* tail_base(const g8::Unit& u) const { return (const char*)(S16 + (size_t)u.pm * 256 * D + u.pn * 256); }
    __device__ __forceinline__ unsigned tail_voff(int wr, int wc, int lane) const { return (unsigned)(((wr * 64 + (lane & 15)) * D + wc * 32 + 8 * (lane >> 4)) * 2); }
    __device__ __forceinline__ int tail_ld() const { return D; }
    __device__ __forceinline__ void operator()(const f32x4 (&acc)[2][2][4][2], const g8::Unit& u, int wr, int wc, int fr, int fq) const {
        const int wid_ = wr * 4 + wc;
        const unsigned lcol = opaque_u((unsigned)(wc * 32 + 8 * fq));
        const unsigned lrow = opaque_u((unsigned)(wr * 64 + fr));
        f32x4 gv[2][2], bv[2][2];
        if (layer > 0) {
            const char* gb = (const char*)(g_prev + u.pn * 256); const char* bb = (const char*)(b_prev + u.pn * 256);
#pragma unroll
            for (int bj = 0; bj < 2; ++bj)
#pragma unroll
                for (int n = 0; n < 2; ++n) { gv[bj][n] = *(const f32x4*)(gb + (size_t)((lcol + bj * 128 + 4 * n) * 4u)); bv[bj][n] = *(const f32x4*)(bb + (size_t)((lcol + bj * 128 + 4 * n) * 4u)); }
        }
        const size_t ue = (size_t)u.pm * 256 * D + u.pn * 256;
        char* s16b = (char*)(S16 + ue);
        const unsigned row0u = (unsigned)(u.pm * 256);
        float mus[2][4], rstds[2][4];
        if (layer > 0) rows_mu_rstd(stats_prev, row0u, lrow, fq, mus, rstds);
#define E4_OE(i) ((lrow + (unsigned)(((i) >> 3) * 128 + (((i) >> 1) & 3) * 16)) * D + lcol + (unsigned)(((i) & 1) * 128))
        float ps = 0.f, pq = 0.f;
#define E4_TAIL(i, X0, X1) { const int ai = (i) >> 3, m = ((i) >> 1) & 3, bj = (i) & 1; const unsigned rl = lrow + (unsigned)(ai * 128 + m * 16); \
            const f32x4 s0 = ALPHA * X0 + acc[ai][bj][m][0], s1 = ALPHA * X1 + acc[ai][bj][m][1]; \
            st16(s16b + (size_t)(E4_OE(i) * 2u), pk8h(s0, s1)); \
            ps += ((s0[0] + s0[1]) + (s0[2] + s0[3])) + ((s1[0] + s1[1]) + (s1[2] + s1[3])); \
            pq += ((s0[0] * s0[0] + s0[1] * s0[1]) + (s0[2] * s0[2] + s0[3] * s0[3])) + ((s1[0] * s1[0] + s1[1] * s1[1]) + (s1[2] * s1[2] + s1[3] * s1[3])); \
            if (bj == 1) { ps += __shfl_xor(ps, 16); ps += __shfl_xor(ps, 32); pq += __shfl_xor(pq, 16); pq += __shfl_xor(pq, 32); \
                if (fq == 0) tab[rl * 4 + wc] = (f32x2){ps, pq}; ps = 0.f; pq = 0.f; } \
            asm volatile("" ::: "memory"); }
        {
            u32x4 h2 = *(const u32x4*)(s16b + (size_t)(E4_OE(14) * 2u)), h3 = *(const u32x4*)(s16b + (size_t)(E4_OE(15) * 2u));
            asm volatile("s_waitcnt vmcnt(0)" ::: "memory");
            const LAS unsigned char* lp = ldsb + wid_ * 1024 + opaque_u((unsigned)lane_id()) * 16u;
#define E4_SLOT(c) ((c) == 0 ? 4 : (c) == 1 ? 5 : (c) == 2 ? 0 : (c) == 3 ? 1 : (c) == 4 ? 6 : (c) == 5 ? 7 : 2)
#define E4_STEP(i, HS) { const u32x4 ch = (i) < 14 ? *(const LAS u32x4*)(lp + E4_SLOT((i) >> 1) * 16384 + ((i) & 1) * 8192) : ((i) == 14 ? h2 : h3); \
                float sv[8]; unpk8h(ch, sv); f32x4 x0, x1; \
                if (layer > 0) { const float mu = mus[(i) >> 3][((i) >> 1) & 3], rstd = rstds[(i) >> 3][((i) >> 1) & 3]; \
                    _Pragma("unroll") for (int e = 0; e < 4; ++e) { x0[e] = (sv[e] - mu) * rstd * gv[(i) & 1][0][e] + bv[(i) & 1][0][e]; x1[e] = (sv[4 + e] - mu) * rstd * gv[(i) & 1][1][e] + bv[(i) & 1][1][e]; } } \
                else { _Pragma("unroll") for (int e = 0; e < 4; ++e) { x0[e] = sv[e]; x1[e] = sv[4 + e]; } } \
                E4_TAIL(i, x0, x1) }
#pragma unroll
            for (int i0 = 0; i0 < 16; i0 += 4) { E4_STEP(i0, h0) E4_STEP(i0 + 1, h1) E4_STEP(i0 + 2, h2) E4_STEP(i0 + 3, h3) }
#undef E4_STEP
#undef E4_SLOT
        }
#undef E4_TAIL
#undef E4_OE
        LDS_WAIT(); G8_BAR; asm volatile("" ::: "memory");
        const unsigned t = opaque_u((unsigned)(wid_ * 64 + lane_id()));
        if (t < 256u) { const f32x2 a = tab[t * 4 + 0], b = tab[t * 4 + 1], c = tab[t * 4 + 2], d = tab[t * 4 + 3];
            *(f32x2*)((char*)stats_out + (size_t)((row0u + t) * 32u + (unsigned)u.pn * 8u)) = (f32x2){(a.x + b.x) + (c.x + d.x), (a.y + b.y) + (c.y + d.y)}; }
    }
};

template <int RM, int CN>
__device__ __forceinline__ void small_tile_partial(const f16* A, int lda, const f16* Bt, int ldb, int kbeg, int ksteps, LAS unsigned char* lds, int wave, int lane) {
    const int r = lane & 15, q = lane >> 4;
    const f16* ap = A + (size_t)r * lda + kbeg + 8 * q;
    const f16* bp = Bt + (size_t)r * ldb + kbeg + 8 * q;
    f32x4 acc[RM][CN];
#pragma unroll
    for (int i = 0; i < RM; ++i)
#pragma unroll
        for (int j = 0; j < CN; ++j) acc[i][j] = (f32x4){0.f, 0.f, 0.f, 0.f};
#pragma unroll 4
    for (int s = 0; s < ksteps; ++s) {
        f16x8 af[RM], bf[CN];
#pragma unroll
        for (int i = 0; i < RM; ++i) af[i] = *(const f16x8*)(ap + (size_t)(16 * i) * lda + 32 * s);
#pragma unroll
        for (int j = 0; j < CN; ++j) bf[j] = *(const f16x8*)(bp + (size_t)(16 * j) * ldb + 32 * s);
#pragma unroll
        for (int i = 0; i < RM; ++i)
#pragma unroll
            for (int j = 0; j < CN; ++j) acc[i][j] = __builtin_amdgcn_mfma_f32_16x16x32_f16(af[i], bf[j], acc[i][j], 0, 0, 0);
    }
    constexpr int COLS = 16 * CN, ROWS = 16 * RM;
    constexpr int LD = COLS + 4;
    LAS float* P = (LAS float*)lds + (size_t)wave * ROWS * LD;
#pragma unroll
    for (int i = 0; i < RM; ++i)
#pragma unroll
        for (int j = 0; j < CN; ++j)
#pragma unroll
            for (int e = 0; e < 4; ++e) P[(16 * i + 4 * q + e) * LD + 16 * j + r] = acc[i][j][e];
}
template <int ROWS, int COLS>
__device__ __forceinline__ void small_tile_sum(const LAS unsigned char* lds, int w0, int w1, int row, int c8, float (&v)[8]) {
#pragma unroll
    for (int e = 0; e < 8; ++e) v[e] = 0.f;
    for (int w = w0; w < w1; ++w) { const LAS f32x4* p = (const LAS f32x4*)((const LAS float*)lds + ((size_t)w * ROWS + row) * (COLS + 4) + c8); const f32x4 a = p[0], b = p[1];
#pragma unroll
        for (int e = 0; e < 4; ++e) { v[e] += a[e]; v[4 + e] += b[e]; } }
}

#define XB_TMO      128
#define XB_XCNT(j)  (256  + 64 * (j))
#define XB_XSUB(j)  (1280 + 64 * (j))
#define XB_XGEN(j)  (2304 + 64 * (j))
#define XB_TOP      3328
#define XB_TOPGEN   3392
#define XCD_BAR_WORDS 3456
#define XB_SPIN_CAP (1u << 20)
__device__ __forceinline__ unsigned xb_ld(unsigned* p)              { return __hip_atomic_load(p, __ATOMIC_RELAXED, __HIP_MEMORY_SCOPE_AGENT); }
__device__ __forceinline__ unsigned xb_add(unsigned* p, unsigned v) { return __hip_atomic_fetch_add(p, v, __ATOMIC_RELAXED, __HIP_MEMORY_SCOPE_AGENT); }
__device__ __forceinline__ unsigned xb_xcc_id() { return (unsigned)__builtin_amdgcn_s_getreg((3 << 11) | 20) & 0xFu; }
#define XB_SPIN(cond, bar) do { unsigned _sp = 0; while (cond) { __builtin_amdgcn_s_sleep(1); \
    if ((++_sp & 255u) == 0u) { if (xb_ld(&(bar)[XB_TMO])) break; if (_sp > XB_SPIN_CAP) { atomicAdd(&(bar)[XB_TMO], 1u); break; } } } } while (0)
struct XcdBarrier { unsigned* bar; unsigned x; volatile LAS unsigned* st; };
__device__ __forceinline__ XcdBarrier xcd_barrier_post(unsigned* bar, volatile LAS unsigned* st, bool t0) {
    XcdBarrier b; b.bar = bar; b.x = xb_xcc_id(); b.st = st;
    if (t0) (void)xb_add(&bar[XB_XCNT(b.x)], 1u);
    return b;
}
__device__ __forceinline__ void xcd_barrier_complete(unsigned* bar, unsigned x, unsigned& nloc, unsigned& nx) {
    const unsigned G = gridDim.x * gridDim.y * gridDim.z;
    unsigned sum, cnt, mine, sp = 0u;
    for (;;) {
        sum = 0u; cnt = 0u; mine = 0u;
#pragma unroll
        for (unsigned j = 0; j < 16; ++j) { const unsigned c = xb_ld(&bar[XB_XCNT(j)]); sum += c; cnt += (c > 0u) ? 1u : 0u; mine = (j == x) ? c : mine; }
        if (sum == G) break;
        __builtin_amdgcn_s_sleep(1);
        if ((++sp & 255u) == 0u) { if (xb_ld(&bar[XB_TMO])) break; if (sp > XB_SPIN_CAP) { atomicAdd(&bar[XB_TMO], 1u); break; } }
    }
    nloc = mine > 0u ? mine : 1u; nx = cnt > 0u ? cnt : 1u;
}
__device__ __forceinline__ void xcd_barrier(const XcdBarrier& b, bool t0) {
    asm volatile("s_waitcnt vmcnt(0)" ::: "memory");
    __syncthreads();
    if (t0) {
        unsigned* bar = b.bar;
        __builtin_amdgcn_s_waitcnt(0);
        unsigned nloc = b.st[0], nx = b.st[1];
        if (nloc == 0u) { xcd_barrier_complete(bar, b.x, nloc, nx); b.st[0] = nloc; b.st[1] = nx; }
        const unsigned old = xb_add(&bar[XB_XSUB(b.x)], 1u);
        const unsigned gen = old / nloc;
        if (old + 1u == (gen + 1u) * nloc) {
            __builtin_amdgcn_fence(__ATOMIC_RELEASE, "agent");
            asm volatile("s_waitcnt vmcnt(0)" ::: "memory");
            const unsigned og = xb_add(&bar[XB_TOP], 1u);
            const unsigned tg = og / nx;
            if (og + 1u == (tg + 1u) * nx) xb_add(&bar[XB_TOPGEN], 1u);
            else XB_SPIN(xb_ld(&bar[XB_TOPGEN]) == tg, bar);
            __builtin_amdgcn_fence(__ATOMIC_ACQUIRE, "agent");
            xb_add(&bar[XB_XGEN(b.x)], 1u);
            asm volatile("s_waitcnt vmcnt(0)" ::: "memory");
        } else {
            XB_SPIN(xb_ld(&bar[XB_XGEN(b.x)]) == gen, bar);
            __builtin_amdgcn_fence(__ATOMIC_ACQUIRE, "agent");
            asm volatile("s_waitcnt vmcnt(0)" ::: "memory");
        }
    }
    __syncthreads();
}

constexpr int PROBE_PH = -1, PROBE_REP = 4, PROBE_FLAGS = 0;
struct Args {
    const float* in[20]; float* out; unsigned char* ws; int ph_lo, ph_hi, flags, pad;
};

struct GainBlk { f32x4 g0, g1, b0, b1; };
__device__ __forceinline__ GainBlk load_gains(const float* gsc, const float* bsh, int k0, int c) {
    GainBlk r; const f32x4 one = {1.f, 1.f, 1.f, 1.f}, zero = {0.f, 0.f, 0.f, 0.f};
    r.g0 = gsc ? *(const f32x4*)(gsc + k0 + 8 * c) : one; r.g1 = gsc ? *(const f32x4*)(gsc + k0 + 8 * c + 4) : one;
    r.b0 = bsh ? *(const f32x4*)(bsh + k0 + 8 * c) : zero; r.b1 = bsh ? *(const f32x4*)(bsh + k0 + 8 * c + 4) : zero;
    return r;
}
__device__ __forceinline__ void transpose_block(LAS float* scr, int lane, int k0, f16* WT, int ldo, const GainBlk& gb, float (&s1)[4], float (&s2)[4]) {
    const int c = lane & 7;
    LDS_WAIT(); asm volatile("" ::: "memory");
    float gk[8], bk[8];
#pragma unroll
    for (int e = 0; e < 4; ++e) { gk[e] = gb.g0[e]; gk[4 + e] = gb.g1[e]; bk[e] = gb.b0[e]; bk[4 + e] = gb.b1[e]; }
#pragma unroll
    for (int j = 0; j < 4; ++j) { const int n = (lane >> 3) + 8 * j; const LAS float* s = scr + (8 * c) * 33 + n;
        f16x8 h;
#pragma unroll
        for (int e = 0; e < 8; ++e) { const float w = s[e * 33]; h[e] = (f16)(w * gk[e]); s1[j] += (float)h[e]; s2[j] += bk[e] * w; }
        *(f16x8*)(WT + (size_t)n * ldo + k0 + 8 * c) = h; }
    LDS_WAIT(); asm volatile("" ::: "memory");
}
template <class F>
__device__ __forceinline__ void transpose_cols32(const float* W, int NKB, int ldw, F colf, f16* WT, int ldo, const float* gsc, const float* bsh,
                                                 float* c1o, float* c2o, const float* badd, LAS float* scr, int lane) {
    float s1[4] = {0.f, 0.f, 0.f, 0.f}, s2[4] = {0.f, 0.f, 0.f, 0.f};
    const float* wp = W + (size_t)(lane >> 3) * ldw + colf(lane & 7);
    LAS float* d0 = scr + (lane >> 3) * 33 + 4 * (lane & 7);
    f32x4 xa[8], xb[8];
#pragma unroll
    for (int i = 0; i < 8; ++i) { xa[i] = __builtin_nontemporal_load((const f32x4*)(wp + (size_t)(8 * i) * ldw)); xb[i] = __builtin_nontemporal_load((const f32x4*)(wp + (size_t)(64 + 8 * i) * ldw)); }
    GainBlk ga = load_gains(gsc, bsh, 0, lane & 7), gb = load_gains(gsc, bsh, 64, lane & 7);
    for (int kb = 0; kb < NKB; kb += 2) {
#pragma unroll
        for (int i = 0; i < 8; ++i) { LAS float* d = d0 + (8 * i) * 33; d[0] = xa[i][0]; d[1] = xa[i][1]; d[2] = xa[i][2]; d[3] = xa[i][3]; }
        const GainBlk gcur = ga;
        if (kb + 2 < NKB) {
            ga = load_gains(gsc, bsh, 64 * (kb + 2), lane & 7);
#pragma unroll
            for (int i = 0; i < 8; ++i) xa[i] = __builtin_nontemporal_load((const f32x4*)(wp + (size_t)(64 * (kb + 2) + 8 * i) * ldw)); }
        transpose_block(scr, lane, 64 * kb, WT, ldo, gcur, s1, s2);
#pragma unroll
        for (int i = 0; i < 8; ++i) { LAS float* d = d0 + (8 * i) * 33; d[0] = xb[i][0]; d[1] = xb[i][1]; d[2] = xb[i][2]; d[3] = xb[i][3]; }
        const GainBlk gcur2 = gb;
        if (kb + 3 < NKB) {
            gb = load_gains(gsc, bsh, 64 * (kb + 3), lane & 7);
#pragma unroll
            for (int i = 0; i < 8; ++i) xb[i] = __builtin_nontemporal_load((const f32x4*)(wp + (size_t)(64 * (kb + 3) + 8 * i) * ldw)); }
        transpose_block(scr, lane, 64 * (kb + 1), WT, ldo, gcur2, s1, s2);
    }
    if (c1o) {
        const int c = lane & 7;
#pragma unroll
        for (int j = 0; j < 4; ++j) { float a = s1[j], b = s2[j];
            a += __shfl_xor(a, 1); a += __shfl_xor(a, 2); a += __shfl_xor(a, 4); b += __shfl_xor(b, 1); b += __shfl_xor(b, 2); b += __shfl_xor(b, 4);
            const int n = (lane >> 3) + 8 * j;
            if (c == 0) { c1o[n] = a; c2o[n] = b + badd[colf(n >> 2) + (n & 3)]; } }
    }
}
template <class F, class R>
__device__ __forceinline__ void transpose_tile256(const float* W, int ldw, F colf, R rowf, f16* WT, int ldo, const float* gsc, const float* bsh,
                                                  float* c1o, float* c2o, const float* badd, LAS unsigned char* lds, int wave, int lane) {
    LAS float* T = (LAS float*)lds;
    const float* wp = W + (size_t)(wave * 16) * ldw + colf(lane);
    const int c = lane & 15, q = lane >> 4;
    float s1[8], s2[8];
#pragma unroll
    for (int j = 0; j < 8; ++j) { s1[j] = 0.f; s2[j] = 0.f; }
    f32x4 x[16];
#pragma unroll
    for (int i = 0; i < 16; ++i) x[i] = __builtin_nontemporal_load((const f32x4*)(wp + (size_t)i * ldw));
    const unsigned wbase = (unsigned)((wave * 16) * 256 + 32 * (lane >> 3)), wn = (unsigned)(4 * (lane & 7));
    for (int kt = 0; kt < 8; ++kt) {
        const GainBlk gb = load_gains(gsc, bsh, 128 * kt, c);
#pragma unroll
        for (int i = 0; i < 16; ++i) { *(LAS f32x4*)(T + wbase + (unsigned)(i * 256) + (wn ^ (unsigned)((((2 * wave + (i >> 3)) & 7) << 2)))) = x[i];
            if (kt + 1 < 8) x[i] = __builtin_nontemporal_load((const f32x4*)(wp + (size_t)(128 * (kt + 1) + i) * ldw)); }
        LDS_WAIT(); __syncthreads();
        float gk[8], bk[8];
#pragma unroll
        for (int e = 0; e < 4; ++e) { gk[e] = gb.g0[e]; gk[4 + e] = gb.g1[e]; bk[e] = gb.b0[e]; bk[4 + e] = gb.b1[e]; }
#pragma unroll
        for (int j = 0; j < 8; ++j) { const int nl = q + 4 * j; const LAS float* sp = T + (8 * c) * 256 + 32 * wave + (nl ^ ((c & 7) << 2));
            f16x8 h;
#pragma unroll
            for (int e = 0; e < 8; ++e) { const float w = sp[e * 256]; h[e] = (f16)(w * gk[e]); s1[j] += (float)h[e]; s2[j] += bk[e] * w; }
            *(f16x8*)(WT + (size_t)rowf(32 * wave + nl) * ldo + 128 * kt + 8 * c) = h; }
        LDS_WAIT(); __syncthreads();
    }
    if (c1o) {
#pragma unroll
        for (int j = 0; j < 8; ++j) { float a = s1[j], b = s2[j];
#pragma unroll
            for (int o = 1; o < 16; o <<= 1) { a += __shfl_xor(a, o); b += __shfl_xor(b, o); }
            const int n = 32 * wave + q + 4 * j;
            if (c == 0) { const int ro = rowf(n); c1o[ro] = a; c2o[ro] = b + badd[colf(n >> 2) + (n & 3)]; } }
    }
}
__device__ __forceinline__ void p0_prologue(const Args& A, LAS unsigned char* lds, int vcu, int G, int wave, int lane) {
    LAS float* scr = (LAS float*)(lds + wave * 16384);
    const int gw = vcu * 8 + wave, NGW = G * 8;
    const float* w_in = A.in[5]; const float* b_in = A.in[6]; const float* ln_g = A.in[18]; const float* ln_b = A.in[19];
    f16* WIN = (f16*)(A.ws + WS_WIN); f16* WRC = (f16*)(A.ws + WS_WRC); f16* WO = (f16*)(A.ws + WS_WO); f16* WG = (f16*)(A.ws + WS_WG);
    float* C1 = (float*)(A.ws + WS_C1); float* C2 = (float*)(A.ws + WS_C2);
    constexpr int I_IN = DEPTH * 256, I_SQ = 3 * DEPTH * 32, I_G = DEPTH * NHEAD * 2 * 4;
    const bool coop = (G == 256);
    if (coop && vcu < 176) {
        const int it = vcu;
        if (it < 128) {
            const int l = it >> 5, t = it & 31;
            const auto cf = [=](int c4g) { return 256 * t + 4 * c4g; };
            const auto rf = [=](int nloc) { const int sc = 256 * t + nloc, b = sc >> 10, w = sc & 1023;
                if (b < 2) return (w >> 7) * 256 + b * 128 + (w & 127);
                if (b >= 6) return (24 + (w >> 7)) * 256 + (b - 6) * 128 + (w & 127);
                const int k = w >> 6, r = w & 63, wcb = r >> 4, h = (r >> 2) & 3, e = r & 3, bj = (b >= 4) ? 1 : 0, par = (b == 3 || b == 4) ? 1 : 0;
                return (8 + k) * 256 + 128 * bj + 32 * wcb + 4 * (2 * h + par) + e; };
            transpose_tile256(w_in + (size_t)l * D * NIN, NIN, cf, rf, WIN + (size_t)l * NIN * D, D,
                              l > 0 ? ln_g + (l - 1) * D : nullptr, l > 0 ? ln_b + (l - 1) * D : nullptr,
                              C1 + l * NIN, C2 + l * NIN, b_in + (size_t)l * NIN, lds, wave, lane);
        } else {
            const int r = it - 128, mat = r >> 4, l = (r >> 2) & 3, nb = r & 3;
            const float* W = A.in[15 + mat] + (size_t)l * D * D;
            const auto cf = [=](int c4g) { return nb * 256 + 4 * c4g; };
            const auto idf = [](int n) { return n; };
            if (mat < 2) transpose_tile256(W, D, cf, idf, WRC + ((size_t)l * D + nb * 256) * 2048 + mat * 1024, 2048, nullptr, nullptr, nullptr, nullptr, nullptr, lds, wave, lane);
            else transpose_tile256(W, D, cf, idf, WO + ((size_t)l * D + nb * 256) * D, D, nullptr, nullptr, nullptr, nullptr, nullptr, lds, wave, lane);
        }
    }
    const int lgw = coop ? (vcu - 176) * 8 + wave : gw, lng = coop ? 640 : NGW;
    for (int it = gw; it < I_IN + I_SQ && !coop; it += NGW) {
        if (it < I_IN) {
            const int l = it >> 8, rb = it & 255, rho0 = rb * 32, pn = rho0 >> 8, bj = (rho0 >> 7) & 1, i0 = rho0 & 127;
            int cA, cB, st;
            if (pn < 8) { cA = (bj ? 1 : 0) * 1024 + 128 * pn + i0; cB = cA + 4; st = 8; }
            else if (pn < 24) { const int k = pn - 8, wcb = i0 >> 5; cA = (bj == 0 ? 2 : 5) * 1024 + 64 * k + 16 * wcb; cB = (bj == 0 ? 3 : 4) * 1024 + 64 * k + 16 * wcb; st = 4; }
            else { cA = (bj ? 7 : 6) * 1024 + 128 * (pn - 24) + i0; cB = cA + 4; st = 8; }
            transpose_cols32(w_in + (size_t)l * D * NIN, 16, NIN, [=](int c4) { return ((c4 & 1) ? cB : cA) + st * (c4 >> 1); }, WIN + ((size_t)l * NIN + rho0) * D, D,
                             l > 0 ? ln_g + (l - 1) * D : nullptr, l > 0 ? ln_b + (l - 1) * D : nullptr,
                             C1 + l * NIN + rho0, C2 + l * NIN + rho0, b_in + (size_t)l * NIN, scr, lane);
        } else {
            const int r = it - I_IN, mat = r / (DEPTH * 32), l = (r / 32) % DEPTH, nb = r & 31;
            const float* W = A.in[15 + mat] + (size_t)l * D * D;
            if (mat < 2) transpose_cols32(W, 16, D, [=](int c4) { return nb * 32 + 4 * c4; }, WRC + ((size_t)l * D + nb * 32) * 2048 + mat * 1024, 2048, nullptr, nullptr, nullptr, nullptr, nullptr, scr, lane);
            else transpose_cols32(W, 16, D, [=](int c4) { return nb * 32 + 4 * c4; }, WO + ((size_t)l * D + nb * 32) * D, D, nullptr, nullptr, nullptr, nullptr, nullptr, scr, lane);
        }
    }
    for (int it = lgw; it < I_G && lgw >= 0; it += lng) {
        const int nb = it & 3, which = (it >> 2) & 1, j = (it >> 3) & 7, l = it >> 6;
        const float* W = A.in[which ? 11 : 9] + ((size_t)(l * NHEAD + j)) * HB * HB;
        transpose_cols32(W, 2, HB, [=](int c4) { return nb * 32 + 4 * c4; }, WG + ((size_t)((l * NHEAD + j) * 2 + which) * HB + nb * 32) * HB, HB, nullptr, nullptr, nullptr, nullptr, nullptr, scr, lane);
    }
    f16* X16 = (f16*)(A.ws + WS_S16);
    for (int m0 = lgw; m0 < M && lgw >= 0; m0 += 4 * lng) {
        f32x4 v[4][4];
#pragma unroll
        for (int r = 0; r < 4; ++r) { const int m = m0 + r * lng; if (m < M) { const float* xr = (m < MP) ? A.in[0] + (size_t)m * D : A.in[1] + (size_t)(m - MP) * D;
#pragma unroll
            for (int jj = 0; jj < 4; ++jj) v[r][jj] = __builtin_nontemporal_load((const f32x4*)(xr + 4 * lane + 256 * jj)); } }
#pragma unroll
        for (int r = 0; r < 4; ++r) { const int m = m0 + r * lng; if (m < M) {
#pragma unroll
            for (int jj = 0; jj < 4; ++jj) { u32x2 w; w.x = pk2h(v[r][jj][0], v[r][jj][1]); w.y = pk2h(v[r][jj][2], v[r][jj][3]); *(u32x2*)(X16 + (size_t)m * D + 4 * lane + 256 * jj) = w; } } }
    }
    { constexpr unsigned n16 = (unsigned)((WS_CGRAN + (size_t)64 * 16 * 2 * 64 * 8 - WS_GRAN) / 16);
      u32x4 zv = (u32x4){0u, 0u, 0u, 0u}; asm volatile("" : "+v"(zv));
      for (unsigned i = (unsigned)(gw * 64 + lane); i < n16; i += (unsigned)(NGW * 64)) *(u32x4*)(A.ws + WS_GRAN + (size_t)(i * 16u)) = zv; }
    float* NSP = (float*)(A.ws + WS_NSP);
    for (int i = gw * 64 + lane; i < DEPTH * D; i += NGW * 64) { const float lam = A.in[13][i];
        const float t = fexp2(-LOG2E * fmaxf(lam, -80.f));
        const float sp_small = t * (1.f - t * (0.5f - t * (1.f / 3.f - t * (0.25f - t * 0.2f))));
        const float sp_big = LN2 * __builtin_amdgcn_logf(1.f + t);
        NSP[i] = -8.f * LOG2E * (t < 0.125f ? sp_small : sp_big); }
}

__global__ void __launch_bounds__(512, 2) hawk_fwd(Args args) {
    extern __shared__ __attribute__((aligned(16))) unsigned char lds_raw[];
    LAS unsigned char* lds = (LAS unsigned char*)lds_raw;
    const int wave_s0 = __builtin_amdgcn_readfirstlane(threadIdx.x >> 6);
    const int G = gridDim.x, bx0 = blockIdx.x, vcu0 = (G % 8 == 0) ? (bx0 % 8) * (G / 8) + bx0 / 8 : bx0;
    unsigned* ctl = (unsigned*)(args.ws + WS_CTL);
    volatile LAS unsigned* MISC = (volatile LAS unsigned*)(lds + MISC_OFF);
    if (wave_s0 == 0) MISC[lane_id()] = 0u;
    __syncthreads();
    XcdBarrier bar = xcd_barrier_post(ctl + CW_BAR, MISC + 8, wave_s0 == 0 && lane_id() == 0);
    const int lo = args.ph_lo, hi = args.ph_hi;
    for (int ph = lo; ph < hi; ++ph) {
        const int l = (ph - 1) / 3, k = (ph - 1) % 3;
        unsigned char* ws = (unsigned char*)(GAS unsigned char*)opaque_s64((unsigned long long)args.ws);
        const int wave_s = opaque_s(wave_s0), bx = opaque_s(bx0), vcu = opaque_s(vcu0);
        {
        f16* S16 = (f16*)(ws + WS_S16); f16* Qb = (f16*)(ws + WS_Q); f16* Pb = (f16*)(ws + WS_P);
        f16* GR = (f16*)(ws + WS_GR); f16* GC = (f16*)(ws + WS_GC); f16* U = (f16*)(ws + WS_U); f16* M16 = (f16*)(ws + WS_M16);
        float* STATS = (float*)(ws + WS_STATS);
        float* out = args.out;
        const float* stats_prev = (l > 0) ? STATS + (size_t)((l - 1) & 1) * M * 8 : nullptr;
        float* stats_cur = STATS + (size_t)(l & 1) * M * 8;
        const float* sstats_prev = (const float*)(ws + WS_SSTAT) + (size_t)((l - 1) & 1) * MS * 32; float* sstats_cur = (float*)(ws + WS_SSTAT) + (size_t)(l & 1) * MS * 32;
        if (ph == 0) {
            p0_prologue(args, lds, vcu, G, wave_s, opaque_v(lane_id()));
        } else if (ph == 1 + 3 * DEPTH) {
            const float* st = STATS + (size_t)((DEPTH - 1) & 1) * M * 8; const float* gg = (const float*)(GAS const float*)opaque_s64((unsigned long long)(args.in[18] + (size_t)(DEPTH - 1) * D)); const float* bb = (const float*)(GAS const float*)opaque_s64((unsigned long long)(args.in[19] + (size_t)(DEPTH - 1) * D));
            const int lane = opaque_v(lane_id()), wave = wave_s;
            const int gw = vcu * 8 + wave, NGW = G * 8;
            const float* sst = (const float*)(ws + WS_SSTAT) + (size_t)((DEPTH - 1) & 1) * MS * 32;
            f32x4 gv[4], bv[4];
#pragma unroll
            for (int jj = 0; jj < 4; ++jj) { gv[jj] = *(const f32x4*)(gg + 8 * lane + 512 * (jj >> 1) + 4 * (jj & 1)); bv[jj] = *(const f32x4*)(bb + 8 * lane + 512 * (jj >> 1) + 4 * (jj & 1)); }
#define P5_LOAD(r, m) { sa[r] = *(const f32x4*)((const char*)st + (size_t)((unsigned)(m) * 32u)); sb[r] = *(const f32x4*)((const char*)st + (size_t)((unsigned)(m) * 32u + 16u)); \
                hv[r][0] = *(const u32x4*)(S16 + (size_t)(m) * D + 8 * lane); hv[r][1] = *(const u32x4*)(S16 + (size_t)(m) * D + 512 + 8 * lane); }
#define P5_ROW(r, m) { const float sum = (sa[r][0] + sa[r][2]) + (sb[r][0] + sb[r][2]), sq = (sa[r][1] + sa[r][3]) + (sb[r][1] + sb[r][3]); \
                float mu = sum * (1.f / D); const float var = sq * (1.f / D) - mu * mu; float rstd = __builtin_amdgcn_rsqf(var + LN_EPS); \
                if ((m) >= MP) row_mu_rstd_s(sst, (unsigned)((m) - MP), mu, rstd);       \
                float* yr = out + O_Y + (size_t)(m) * D; \
                _Pragma("unroll") for (int h = 0; h < 2; ++h) { float sv[8]; unpk8h(hv[r][h], sv); f32x4 y0, y1; \
                    _Pragma("unroll") for (int e = 0; e < 4; ++e) { y0[e] = (sv[e] - mu) * rstd * gv[2 * h][e] + bv[2 * h][e]; y1[e] = (sv[4 + e] - mu) * rstd * gv[2 * h + 1][e] + bv[2 * h + 1][e]; } \
                    __builtin_nontemporal_store(y0, (f32x4*)(yr + 512 * h + 8 * lane)); __builtin_nontemporal_store(y1, (f32x4*)(yr + 512 * h + 8 * lane + 4)); } }
            int m0 = gw;
            for (; m0 + NGW < M; m0 += 2 * NGW) { f32x4 sa[2], sb[2]; u32x4 hv[2][2]; P5_LOAD(0, m0) P5_LOAD(1, m0 + NGW) P5_ROW(0, m0) P5_ROW(1, m0 + NGW) }
            if (m0 < M) { f32x4 sa[1], sb[1]; u32x4 hv[1][2]; P5_LOAD(0, m0) P5_ROW(0, m0) }
#undef P5_LOAD
#undef P5_ROW
        } else if (k == 0) {
            g8::Gemm gm{S16, (const f16*)(ws + WS_WIN) + (size_t)l * NIN * D, M, NIN, D}; g8::StaticOrder S; S.init(M, NIN, G, bx); if (G == 256) S.mode = 1;
            Epi1 E{ws, (const float*)(ws + WS_C1) + l * NIN, (const float*)(ws + WS_C2) + l * NIN, stats_prev, out, l,
                   MixCtx{U, (const f16*)(ws + WS_WG) + (size_t)l * NHEAD * 2 * HB * HB,
                          args.in[7] + (size_t)l * 4 * D, args.in[8] + (size_t)l * D, args.in[10] + (size_t)l * D, args.in[12] + (size_t)l * D, (const float*)(ws + WS_NSP) + l * D,
                          args.in[2] + (size_t)l * DECB * D, args.in[3] + (size_t)l * DECB * 3 * D,
                          (unsigned long long*)(ws + WS_GRAN), (unsigned long long*)(ws + WS_HGRAN), (unsigned*)(ws + WS_CTL) + CW_ERR, out, l, args.flags},
                   ConvCtx{U, args.in[14] + (size_t)l * 3 * D, args.in[4] + (size_t)l * DECB * 2 * D, (unsigned long long*)(ws + WS_CGRAN), (unsigned*)(ws + WS_CTL) + CW_ERR, out, l}, lds, -1, C1C2_OFF, sstats_prev};
            g8::gemm_phase<Epi1>(lds, gm, S, E, wave_s, args.flags);
        } else if (k == 1) {
            const f16* WRCl = (const f16*)(ws + WS_WRC) + (size_t)l * D * 2048;
            {
                g8::Gemm gm{U, WRCl, MP, D, 2048}; g8::StaticOrder S; S.init(MP, D, G, bx);
                { const int t = wave_s * 64 + opaque_v(lane_id()); if (t < 256) { const float gq = __builtin_amdgcn_fmed3f(__builtin_amdgcn_cvt_f32_fp8(t, 0), -30.f, 30.f), ie = 1.f + fexp2(-LOG2E * gq);
                    *(LAS float*)(lds + LUT_OFF + 4 * t) = frcp(ie); *(LAS float*)(lds + LUT_OFF + 1024 + 4 * t) = ie; } }
                LDS_WAIT(); __syncthreads();
                Epi3 E{GR, M16, lds + LUT_OFF, lds};
                g8::gemm_phase<Epi3>(lds, gm, S, E, wave_s, args.flags);
            }
            for (int tile = bx; tile < 256 && !(args.flags & 4); tile += G) {
                const int lane = opaque_v(lane_id());
                const int row0 = MP + 64 * (tile >> 4), col0 = 64 * (tile & 15);
                small_tile_partial<4, 4>(U + (size_t)row0 * 2048, 2048, WRCl + (size_t)col0 * 2048, 2048, 256 * wave_s, 8, lds, wave_s, lane);
                LDS_WAIT(); __syncthreads();
                const int t = wave_s * 64 + lane, row = t >> 3, c8 = (t & 7) * 8;
                float yr[8], yc[8]; small_tile_sum<64, 64>(lds, 0, 4, row, c8, yr); small_tile_sum<64, 64>(lds, 4, 8, row, c8, yc);
                const size_t o = (size_t)(row0 + row) * D + col0 + c8;
                const u32x4 gw = *(const u32x4*)(GR + o);
                f32x4 v0, v1;
#define ST_SIG(w, k) (*(const LAS float*)(lds + LUT_OFF + (((w) >> (8 * (k))) & 0xffu) * 4u))
#pragma unroll
                for (int e = 0; e < 4; ++e) { v0[e] = ST_SIG(gw.x, e) * yr[e] + ST_SIG(gw.z, e) * yc[e]; v1[e] = ST_SIG(gw.y, e) * yr[4 + e] + ST_SIG(gw.w, e) * yc[4 + e]; }
#undef ST_SIG
                st16(M16 + o, pk8h(v0, v1));
                LDS_WAIT(); __syncthreads();
            }
        } else {
            const f16* WOl = (const f16*)(ws + WS_WO) + (size_t)l * D * D;
            const float* g_prev = l > 0 ? args.in[18] + (size_t)(l - 1) * D : nullptr; const float* b_prev = l > 0 ? args.in[19] + (size_t)(l - 1) * D : nullptr;
            {
                g8::Gemm gm{M16, WOl, MP, D, D}; g8::StaticOrder S; S.init(MP, D, G, bx);
                Epi4 E{args.in[0], S16, stats_prev, stats_cur, g_prev, b_prev, (LAS f32x2*)(lds + TAB_OFF), l, lds};
                g8::gemm_phase<Epi4>(lds, gm, S, E, wave_s, args.flags);
            }
            for (int tile = bx; tile < 256 && !(args.flags & 4); tile += G) {
                const int lane = opaque_v(lane_id());
                const int ct = tile & 15, row0 = MP + 64 * (tile >> 4), col0 = 64 * ct;
                small_tile_partial<4, 4>(M16 + (size_t)row0 * D, D, WOl + (size_t)col0 * D, D, 128 * wave_s, 4, lds, wave_s, lane);
                LDS_WAIT(); __syncthreads();
                const int t = wave_s * 64 + lane, row = t >> 3, c8 = (t & 7) * 8, grow = row0 + row, col = col0 + c8;
                float a8[8]; small_tile_sum<64, 64>(lds, 0, 8, row, c8, a8);
                float x8[8];
                if (l > 0) { float mu, rstd; row_mu_rstd_s(sstats_prev, (unsigned)(grow - MP), mu, rstd); float sv[8]; unpk8h(*(const u32x4*)(S16 + (size_t)grow * D + col), sv);
                    const f32x4 g0 = *(const f32x4*)(g_prev + col), g1 = *(const f32x4*)(g_prev + col + 4), b0 = *(const f32x4*)(b_prev + col), b1 = *(const f32x4*)(b_prev + col + 4);
#pragma unroll
                    for (int e = 0; e < 4; ++e) { x8[e] = (sv[e] - mu) * rstd * g0[e] + b0[e]; x8[4 + e] = (sv[4 + e] - mu) * rstd * g1[e] + b1[e]; } }
                else unpk8h(*(const u32x4*)(S16 + (size_t)grow * D + col), x8);
                f32x4 s0, s1; float ps = 0.f, pq = 0.f;
#pragma unroll
                for (int e = 0; e < 4; ++e) { s0[e] = ALPHA * x8[e] + a8[e]; s1[e] = ALPHA * x8[4 + e] + a8[4 + e]; ps += s0[e] + s1[e]; pq += s0[e] * s0[e] + s1[e] * s1[e]; }
                st16(S16 + (size_t)grow * D + col, pk8h(s0, s1));
#pragma unroll
                for (int o = 1; o < 8; o <<= 1) { ps += __shfl_xor(ps, o); pq += __shfl_xor(pq, o); }
                if ((t & 7) == 0) *(f32x2*)(sstats_cur + (size_t)(grow - MP) * 32 + ct * 2) = (f32x2){ps, pq};
                LDS_WAIT(); __syncthreads();
            }
        }
        if (ph + 1 < hi) xcd_barrier(bar, wave_s == 0 && lane_id() == 0);
        }
    }
}

extern "C" void kernel_launch(void* const* d_in, const int* in_sizes, int n_in, void* d_out, int out_size, void* d_ws, size_t ws_size, hipStream_t stream) {
    static int grid = 0;
    if (grid == 0) {
        if (n_in != 20 || (size_t)out_size != O_END || ws_size < WS_END) { fprintf(stderr, "kernel_launch: unexpected shapes: n_in %d out %d ws %zu (need %zu)\n", n_in, out_size, ws_size, (size_t)WS_END); grid = -1; return; }
        int dev = 0, cus = 0, per_cu = 0;
        if (hipGetDevice(&dev) != hipSuccess || hipDeviceGetAttribute(&cus, hipDeviceAttributeMultiprocessorCount, dev) != hipSuccess) { grid = -1; return; }
        if (hipFuncSetAttribute((const void*)hawk_fwd, hipFuncAttributeMaxDynamicSharedMemorySize, LDS_BYTES) != hipSuccess) { fprintf(stderr, "kernel_launch: hipFuncSetAttribute failed\n"); grid = -1; return; }
        if (hipOccupancyMaxActiveBlocksPerMultiprocessor(&per_cu, (const void*)hawk_fwd, 512, LDS_BYTES) != hipSuccess || per_cu < 1) { fprintf(stderr, "kernel_launch: occupancy query failed (%d)\n", per_cu); (void)hipGetLastError(); grid = -1; return; }
        grid = cus;
    }
    if (grid < 0) return;
    (void)hipMemsetAsync((char*)d_ws + WS_CTL, 0, WS_GRAN, stream);
    Args a{};
    for (int i = 0; i < 20; ++i) a.in[i] = (const float*)d_in[i];
    a.out = (float*)d_out; a.ws = (unsigned char*)d_ws;
    const int NPH = 2 + 3 * DEPTH;
    int cuts[PROBE_REP + 4]; int nc = 0;
    cuts[nc++] = 0;
    if (PROBE_PH >= 0) { cuts[nc++] = PROBE_PH + 1; for (int r = 0; r < PROBE_REP; ++r) cuts[nc++] = -(PROBE_PH + 1); if (PROBE_FLAGS) cuts[nc++] = -(PROBE_PH + 1) - 1000; }
    cuts[nc++] = NPH;
    int lo = 0;
    for (int i = 1; i < nc; ++i) {
        int hi = cuts[i]; a.flags = 0; if (hi < -1000) { hi += 1000; lo = -hi - 1; hi = -hi; } else if (hi < 0) { lo = -hi - 1; hi = -hi; a.flags = PROBE_FLAGS; }
        a.ph_lo = lo; a.ph_hi = hi;
        if (i > 1) (void)hipMemsetAsync((char*)d_ws + WS_CTL + CW_BAR * 4, 0, XCD_BAR_WORDS * 4, stream);
        void* params[] = {&a};
        hipError_t e = hipLaunchCooperativeKernel((const void*)hawk_fwd, dim3(grid), dim3(512), params, LDS_BYTES, stream);
        if (e != hipSuccess) { fprintf(stderr, "kernel_launch: cooperative launch failed: %s (grid %d)\n", hipGetErrorString(e), grid); break; }
        lo = hi;
    }
}
```
